# Optimizing an MI355X kernel written in HIP

```python
import jax, jax.numpy as jnp
from jax import lax
import numpy as np

D_MODEL = 1024
BATCH = 8
SEQ = 2048
DEPTH = 1
DEC_BATCH = 128
DEC_SEQ = 4
PAST_LEN = 16384
PAGE_SIZE = 128

A_W = 512
CONV_A_K = 3
DN_HEADS = 4
DN_DK = 128
DN_DV = 128
DN_QK = DN_HEADS * DN_DK
DN_V = DN_HEADS * DN_DV
DN_CONV_CH = 2 * DN_QK + DN_V
DN_CONV_K = 4
DN_CHUNK = 64
MEM_TOKENS = 256
XA_HEADS = 4
XA_DH = 128
XA_W = XA_HEADS * XA_DH
N_BRANCH = 3
MIX_WIDTH = A_W + DN_V + XA_W
IN_WIDTH = 3 * A_W + DN_CONV_CH + DN_V + 2 * DN_HEADS + XA_W + N_BRANCH * D_MODEL
D_FF = 256 * (-(-(8 * D_MODEL) // (3 * 256)))
EPS = 1e-6

kernel_name = 'hybrid_gated_conv_deltanet_memxattn_step'


def rmsnorm(x, g):
    xf = x.astype(jnp.float32)
    y = xf * lax.rsqrt(jnp.mean(xf * xf, axis=-1, keepdims=True) + EPS)
    return (y * g.astype(jnp.float32)).astype(x.dtype)


def l2norm(x):
    xf = x.astype(jnp.float32)
    return xf * lax.rsqrt(jnp.sum(xf * xf, axis=-1, keepdims=True) + EPS)


def causal_conv(x, buf, w):
    width = w.shape[0]
    length = x.shape[1]
    xp = jnp.concatenate([buf.astype(x.dtype), x], axis=1)
    y = sum(xp[:, i:i + length] * w[i].astype(x.dtype) for i in range(width))
    return y, xp[:, length:]


def gated_delta_chunked(q, k, v, g, beta, s0):
    bsz, length = q.shape[0], q.shape[1]
    csz = min(DN_CHUNK, length)
    n = -(-length // csz)
    pad = n * csz - length

    def prep(t):
        t = jnp.pad(t, [(0, 0), (0, pad)] + [(0, 0)] * (t.ndim - 2))
        t = t.reshape((bsz, n, csz) + t.shape[2:])
        return jnp.swapaxes(jnp.moveaxis(t, 1, 0), 2, 3)

    qc, kc, vc, gc, bc = prep(q), prep(k), prep(v), prep(g), prep(beta)
    d = jnp.cumsum(gc, axis=-1)
    idx = jnp.arange(csz)
    causal = idx[:, None] >= idx[None, :]
    strict = idx[:, None] > idx[None, :]
    diff = d[..., :, None] - d[..., None, :]
    gamma = jnp.where(causal, jnp.exp(jnp.where(causal, diff, 0.0)), 0.0)
    kk = jnp.einsum('nbhid,nbhjd->nbhij', kc, kc)
    a_mat = jnp.where(strict, bc[..., :, None] * kk * gamma, 0.0)
    eye = jnp.eye(csz, dtype=a_mat.dtype)
    rhs = jnp.concatenate([vc * bc[..., None], kc * (bc * jnp.exp(d))[..., None]], axis=-1)
    sol = lax.linalg.triangular_solve(a_mat + eye, rhs, left_side=True, lower=True, unit_diagonal=True)
    u, w = sol[..., :DN_DV], sol[..., DN_DV:]
    qk = jnp.where(causal, jnp.einsum('nbhid,nbhjd->nbhij', qc, kc) * gamma, 0.0)

    def step(s, inp):
        q_i, k_i, u_i, w_i, qk_i, d_i = inp
        v_new = u_i - jnp.einsum('bhcd,bhde->bhce', w_i, s)
        o = (jnp.einsum('bhcd,bhde->bhce', q_i * jnp.exp(d_i)[..., None], s)
             + jnp.einsum('bhij,bhje->bhie', qk_i, v_new))
        d_last = d_i[..., -1:]
        s = (s * jnp.exp(d_last)[..., None]
             + jnp.einsum('bhcd,bhce->bhde', k_i * jnp.exp(d_last - d_i)[..., None], v_new))
        return s, o

    s_fin, o = lax.scan(step, s0.astype(jnp.float32), (qc, kc, u, w, qk, d))
    o = jnp.moveaxis(jnp.swapaxes(o, 2, 3), 0, 1).reshape(bsz, n * csz, DN_HEADS, DN_DV)[:, :length]
    return o, s_fin.astype(s0.dtype)


def mem_kv(mem, norm_mem_l, w_mem_kv_l):
    kv = rmsnorm(mem, norm_mem_l) @ w_mem_kv_l
    k, v = jnp.split(kv, 2, axis=-1)
    shp = mem.shape[:2] + (XA_HEADS, XA_DH)
    return k.reshape(shp), v.reshape(shp)


def mem_attention(q, mk, mv):
    s = jnp.einsum('blhd,bmhd->bhlm', q, mk.astype(q.dtype)).astype(jnp.float32) * (XA_DH ** -0.5)
    p = jax.nn.softmax(s, axis=-1)
    o = jnp.einsum('bhlm,bmhd->blhd', p.astype(q.dtype), mv.astype(q.dtype))
    return o.reshape(q.shape[0], q.shape[1], XA_W)


def trunk_layer(x, conv_a_buf, dn_conv_buf, dn_s, mk, mv, norm_mix_l, w_in_l, conv_a_w_l,
                dn_conv_w_l, a_log_l, dt_bias_l, dn_norm_l, w_branch_l, w_o_l, norm_ffn_l,
                w_up_l, w_down_l):
    bsz, length = x.shape[0], x.shape[1]
    xn = rmsnorm(x, norm_mix_l)
    proj = xn @ w_in_l
    sizes = (A_W, A_W, A_W, DN_CONV_CH, DN_V, DN_HEADS, DN_HEADS, XA_W, N_BRANCH * D_MODEL)
    offs = [int(o) for o in np.cumsum(sizes)[:-1]]
    b_gate, c_gate, h_in, qkv, z, a_raw, b_raw, xq, gates = jnp.split(proj, offs, axis=-1)
    g_a, g_dn, g_m = jnp.split(gates, N_BRANCH, axis=-1)

    conv_out, conv_a_new = causal_conv(c_gate * h_in, conv_a_buf, conv_a_w_l)
    y_a = b_gate * conv_out

    qkv_c, dn_conv_new = causal_conv(qkv, dn_conv_buf, dn_conv_w_l)
    qkv_c = jax.nn.silu(qkv_c)
    q, k, v = jnp.split(qkv_c, [DN_QK, 2 * DN_QK], axis=-1)
    q = l2norm(q.reshape(bsz, length, DN_HEADS, DN_DK)) * (DN_DK ** -0.5)
    k = l2norm(k.reshape(bsz, length, DN_HEADS, DN_DK))
    v = v.reshape(bsz, length, DN_HEADS, DN_DV).astype(jnp.float32)
    beta = jax.nn.sigmoid(b_raw.astype(jnp.float32))
    g = -jnp.exp(a_log_l.astype(jnp.float32)) * jax.nn.softplus(
        a_raw.astype(jnp.float32) + dt_bias_l.astype(jnp.float32))
    o_dn, dn_s_new = gated_delta_chunked(q, k, v, g, beta, dn_s)
    o_dn = rmsnorm(o_dn, dn_norm_l).astype(x.dtype).reshape(bsz, length, DN_V)
    y_dn = o_dn * jax.nn.silu(z)

    y_m = mem_attention(xq.reshape(bsz, length, XA_HEADS, XA_DH), mk, mv)

    merged = (jax.nn.sigmoid(g_a) * (y_a @ w_branch_l[:A_W])
              + jax.nn.sigmoid(g_dn) * (y_dn @ w_branch_l[A_W:A_W + DN_V])
              + jax.nn.sigmoid(g_m) * (y_m @ w_branch_l[A_W + DN_V:]))
    x = x + merged @ w_o_l

    gate, up = jnp.split(rmsnorm(x, norm_ffn_l) @ w_up_l, 2, axis=-1)
    x = x + (jax.nn.silu(gate) * up) @ w_down_l
    return x, conv_a_new, dn_conv_new, dn_s_new


def setup_inputs(seed: int = 0) -> dict:
    key = jax.random.key(seed)
    ks = jax.random.split(key, 24)
    f32 = jnp.float32

    def nrm(k, shape, scale):
        return jax.random.normal(k, shape, f32) * scale

    def gain(k, shape):
        return 1.0 + 0.05 * jax.random.normal(k, shape, f32)

    dt = jnp.exp(jax.random.uniform(ks[13], (DEPTH, DN_HEADS), f32, np.log(1e-3), np.log(1e-1)))
    return {
        'x_prompt': nrm(ks[0], (BATCH, SEQ, D_MODEL), 1.0),
        'x_sample': nrm(ks[1], (DEC_BATCH, DEC_SEQ, D_MODEL), 1.0),
        'mem_prompt': nrm(ks[2], (BATCH, MEM_TOKENS, D_MODEL), 1.0),
        'state_conv_a': nrm(ks[3], (DEPTH, DEC_BATCH, CONV_A_K - 1, A_W), 1.0),
        'state_dn_conv': nrm(ks[4], (DEPTH, DEC_BATCH, DN_CONV_K - 1, DN_CONV_CH), 1.0),
        'state_dn': nrm(ks[5], (DEPTH, DEC_BATCH, DN_HEADS, DN_DK, DN_DV), 0.1),
        'cache_mem_k': nrm(ks[6], (DEPTH, DEC_BATCH, MEM_TOKENS, XA_HEADS, XA_DH), 1.0),
        'cache_mem_v': nrm(ks[7], (DEPTH, DEC_BATCH, MEM_TOKENS, XA_HEADS, XA_DH), 1.0),
        'norm_mix': gain(ks[8], (DEPTH, D_MODEL)),
        'w_in': nrm(ks[9], (DEPTH, D_MODEL, IN_WIDTH), D_MODEL ** -0.5),
        'conv_a_w': nrm(ks[10], (DEPTH, CONV_A_K, A_W), CONV_A_K ** -0.5),
        'dn_conv_w': nrm(ks[11], (DEPTH, DN_CONV_K, DN_CONV_CH), DN_CONV_K ** -0.5),
        'dn_a_log': jnp.log(jax.random.uniform(ks[12], (DEPTH, DN_HEADS), f32, 1.0, 16.0)),
        'dn_dt_bias': dt + jnp.log(-jnp.expm1(-dt)),
        'dn_norm': gain(ks[14], (DEPTH, DN_DV)),
        'norm_mem': gain(ks[15], (DEPTH, D_MODEL)),
        'w_mem_kv': nrm(ks[16], (DEPTH, D_MODEL, 2 * XA_W), D_MODEL ** -0.5),
        'w_branch': nrm(ks[17], (DEPTH, MIX_WIDTH, D_MODEL), A_W ** -0.5),
        'w_o': nrm(ks[18], (DEPTH, D_MODEL, D_MODEL), D_MODEL ** -0.5),
        'norm_ffn': gain(ks[19], (DEPTH, D_MODEL)),
        'w_ffn_up': nrm(ks[20], (DEPTH, D_MODEL, 2 * D_FF), D_MODEL ** -0.5),
        'w_ffn_down': nrm(ks[21], (DEPTH, D_FF, D_MODEL), D_FF ** -0.5),
        'norm_final': gain(ks[22], (D_MODEL,)),
    }


def reference(x_prompt, x_sample, mem_prompt, state_conv_a, state_dn_conv, state_dn, cache_mem_k,
              cache_mem_v, norm_mix, w_in, conv_a_w, dn_conv_w, dn_a_log, dn_dt_bias, dn_norm,
              norm_mem, w_mem_kv, w_branch, w_o, norm_ffn, w_ffn_up, w_ffn_down, norm_final):
    bp = x_prompt.shape[0]
    hp, hs = x_prompt, x_sample
    ca_p, dc_p, s_p, mk_p, mv_p = [], [], [], [], []
    ca_s, dc_s, s_s = [], [], []
    for l in range(DEPTH):
        layer_w = (norm_mix[l], w_in[l], conv_a_w[l], dn_conv_w[l], dn_a_log[l], dn_dt_bias[l],
                   dn_norm[l], w_branch[l], w_o[l], norm_ffn[l], w_ffn_up[l], w_ffn_down[l])
        mk, mv = mem_kv(mem_prompt, norm_mem[l], w_mem_kv[l])
        zero_ca = jnp.zeros((bp, CONV_A_K - 1, A_W), x_prompt.dtype)
        zero_dc = jnp.zeros((bp, DN_CONV_K - 1, DN_CONV_CH), x_prompt.dtype)
        zero_s = jnp.zeros((bp, DN_HEADS, DN_DK, DN_DV), state_dn.dtype)
        hp, a_new, d_new, st_new = trunk_layer(hp, zero_ca, zero_dc, zero_s, mk, mv, *layer_w)
        ca_p.append(a_new); dc_p.append(d_new); s_p.append(st_new); mk_p.append(mk); mv_p.append(mv)
        hs, a_new, d_new, st_new = trunk_layer(hs, state_conv_a[l], state_dn_conv[l], state_dn[l],
                                               cache_mem_k[l], cache_mem_v[l], *layer_w)
        ca_s.append(a_new); dc_s.append(d_new); s_s.append(st_new)
    y_prompt = rmsnorm(hp, norm_final)
    y_sample = rmsnorm(hs, norm_final)
    return (y_prompt, y_sample, jnp.stack(ca_p), jnp.stack(dc_p), jnp.stack(s_p), jnp.stack(mk_p),
            jnp.stack(mv_p), jnp.stack(ca_s), jnp.stack(dc_s), jnp.stack(s_s))
```

```cpp
#include <hip/hip_runtime.h>
#include <cstdio>
#include <cstdint>

#define LAS __attribute__((address_space(3)))
#define GAS __attribute__((address_space(1)))
typedef unsigned short bf16_t;
typedef short bf16x8 __attribute__((ext_vector_type(8)));
typedef short s16x4 __attribute__((ext_vector_type(4)));
typedef float f32x4 __attribute__((ext_vector_type(4)));
typedef float f32x2 __attribute__((ext_vector_type(2)));
typedef float f32x16 __attribute__((ext_vector_type(16)));
typedef unsigned u32x4 __attribute__((ext_vector_type(4)));
typedef unsigned u32x2 __attribute__((ext_vector_type(2)));
typedef __bf16 bf16x2_t __attribute__((ext_vector_type(2)));
#define DI __device__ __forceinline__

constexpr int DM = 1024, NB = 8, SEQ = 2048, SB = 128, SS = 4;
constexpr int TP = NB * SEQ;
constexpr int TS = SB * SS;
constexpr int T = TP + TS;
constexpr int NP = 7168;
constexpr int INW = 7176;
constexpr int DFF = 2816;
constexpr int MEMT = 256;
constexpr float EPS = 1e-6f;
constexpr int PC_B = 0, PC_C = 512, PC_H = 1024, PC_Q = 1536, PC_K = 2048, PC_V = 2560, PC_Z = 3072, PC_XQ = 3584, PC_G = 4096;

DI unsigned cvtpk(float lo, float hi) { f32x2 v = {lo, hi}; bf16x2_t b = __builtin_convertvector(v, bf16x2_t); return __builtin_bit_cast(unsigned, b); }
DI bf16_t f2bf(float f) { return (bf16_t)(cvtpk(f, 0.f) & 0xffffu); }
DI float bf2f(bf16_t h) { return __uint_as_float(((unsigned)h) << 16); }
DI float bflo(unsigned w) { return __uint_as_float(w << 16); }
DI float bfhi(unsigned w) { return __uint_as_float(w & 0xffff0000u); }
DI float fast_exp(float x) { return __builtin_amdgcn_exp2f(x * 1.4426950408889634f); }
DI float fast_rcp(float x) { return __builtin_amdgcn_rcpf(x); }
DI float sigmoidf_(float x) { return fast_rcp(1.f + fast_exp(-x)); }
DI float siluf_(float x) { return x * sigmoidf_(x); }
DI float wave_sum(float v) {
#pragma unroll
    for (int o = 1; o < 64; o <<= 1) v += __shfl_xor(v, o);
    return v;
}
DI int opaque_v(int x) { asm volatile("" : "+v"(x)); return x; }
DI int opaque_s(int x) { asm volatile("" : "+s"(x)); return x; }
#define LDS_WAIT() asm volatile("s_waitcnt lgkmcnt(0)" ::: "memory")
#define VM_WAIT() asm volatile("s_waitcnt vmcnt(0)" ::: "memory")

namespace pg8 {
constexpr int BM = 256, BK = 64, HALF = 128, HTB = HALF * BK * 2, STAGE_BYTES = 8 * HTB, NXCD = 8, WGM = 8;
__host__ __device__ __forceinline__ int lds_byte(int r, int c) { const int st = (r >> 4) * 2 + (c >> 5), rr = r & 15, cc = c & 31, ob = rr * 64 + cc * 2; return st * 1024 + (ob ^ (((ob >> 9) & 1) << 5)); }
__host__ __device__ __forceinline__ void stage_rc(int b, int& R, int& C) { const int st = b / 1024, sb = b % 1024, swz = sb ^ (((sb >> 9) & 1) << 5); R = (st >> 1) * 16 + swz / 64; C = (st & 1) * 32 + (swz % 64) / 2; }
__host__ __device__ __forceinline__ int perm32(int rho) { const int n = rho >> 4, i = rho & 15; return 8 * (i >> 2) + 4 * n + (i & 3); }

struct Unit { int pm, pn; };
struct Gemm { const bf16_t* A; const bf16_t* Bt; int M, N, K, lda; };

struct StaticOrder {
    int nM, nN, nwg, G, c;
    __device__ void init(int M, int N, int G_, int c_) { nM = M / BM; nN = N / BM; nwg = nM * nN; G = G_; c = c_; }
    __device__ bool next(int i, Unit& u) const {
        const long L = (long)i * G + c; if (L >= nwg) return false;
        int wgid = (int)L; { const int q = nwg / NXCD, r = nwg % NXCD, xcd = wgid % NXCD, off = wgid / NXCD; wgid = (xcd < r ? xcd * (q + 1) : r * (q + 1) + (xcd - r) * q) + off; }
        const int nig = WGM * nN, gid = wgid / nig, fm = gid * WGM, gsz = (nM - fm) < WGM ? (nM - fm) : WGM;
        u.pm = fm + ((wgid % nig) % gsz); u.pn = (wgid % nig) / gsz; return true;
    }
};

typedef f32x4 Acc[2][2][4][2];

template <bool SEG> DI size_t akoff(int t) { if (SEG) { const int s = t >> 3; return (size_t)(t & 7) * 128 + (s == 0 ? 0 : (s == 1 ? (size_t)PC_Z * 2 : (size_t)PC_XQ * 2)); } return (size_t)t * 128; }

template <class Epi, bool SEG, bool ALIGN_EPI, bool SP2>
DI void gemm_phase(LAS unsigned char* lds, const Gemm g, const StaticOrder& S, const Epi& E) {
    const int tid = threadIdx.x, wid = __builtin_amdgcn_readfirstlane(tid >> 6), lane = tid & 63, wr = wid >> 2, wc = wid & 3, fr = lane & 15, fq = lane >> 4;
    const int K = g.K, nt = K / BK, lda = g.lda;
    unsigned voffA[2], voffB[2];
#pragma unroll
    for (int i = 0; i < 2; ++i) { int R, C; stage_rc(tid * 16 + i * 8192, R, C); const int Rb = Epi::PERM ? ((R & ~31) + perm32(R & 31)) : R;
        voffA[i] = (unsigned)(R * lda + C) * 2u; voffB[i] = (unsigned)(Rb * K + C) * 2u; }
    const size_t kstep = (size_t)(BK * 2);
    const size_t hstepA = (size_t)HALF * lda * 2, tstepA = 2 * hstepA;
    const size_t hstepB = (size_t)HALF * K * 2, tstepB = 2 * hstepB;
    const unsigned ldsw = (unsigned)wid * 1024u;
    const int aoff = lds_byte(wr * 64 + fr, fq * 8), boff = lds_byte(wc * 32 + fr, fq * 8);
#define PG8_SA(b, h) (((b) * 2 + (h)) * HTB)
#define PG8_SB(b, h) ((4 + (b) * 2 + (h)) * HTB)
#define PG8_STAGE(bufoff, gbase, voff) do { _Pragma("unroll") for (int _i = 0; _i < 2; ++_i) \
        __builtin_amdgcn_global_load_lds((const unsigned*)((const char*)(gbase) + (voff)[_i]), (LAS unsigned*)(lds + (bufoff) + ldsw + _i * 8192), 16, 0, 0); } while (0)
#define PG8_LDA(dst, b, h) do { _Pragma("unroll") for (int m = 0; m < 4; ++m) _Pragma("unroll") for (int k = 0; k < 2; ++k) dst[m][k] = *(const LAS bf16x8*)(lds + PG8_SA(b, h) + aoff + m * 2048 + k * 1024); } while (0)
#define PG8_LDB(dst, b, h) do { _Pragma("unroll") for (int n = 0; n < 2; ++n) _Pragma("unroll") for (int k = 0; k < 2; ++k) dst[n][k] = *(const LAS bf16x8*)(lds + PG8_SB(b, h) + boff + n * 2048 + k * 1024); } while (0)
#define PG8_MMA(ai, bj, At, Bt) do { __builtin_amdgcn_s_setprio(1); _Pragma("unroll") for (int m = 0; m < 4; ++m) _Pragma("unroll") for (int n = 0; n < 2; ++n) _Pragma("unroll") for (int k = 0; k < 2; ++k) \
        acc[ai][bj][m][n] = __builtin_amdgcn_mfma_f32_16x16x32_bf16(Bt[n][k], At[m][k], acc[ai][bj][m][n], 0, 0, 0); __builtin_amdgcn_s_setprio(0); } while (0)
#define PG8_WAIT_V(n) asm volatile("s_waitcnt vmcnt(" #n ")" ::: "memory")
#define PG8_WAIT_L(n) asm volatile("s_waitcnt lgkmcnt(" #n ")" ::: "memory")
#define PG8_BAR __builtin_amdgcn_s_barrier()
#define PG8_SCHED __builtin_amdgcn_sched_barrier(0)
    Unit cur, nxt; int ui = 0;
    if (!S.next(0, cur)) return;
    Acc acc;
#pragma unroll
    for (int a = 0; a < 2; ++a)
#pragma unroll
        for (int b = 0; b < 2; ++b)
#pragma unroll
            for (int m = 0; m < 4; ++m)
#pragma unroll
                for (int n = 0; n < 2; ++n) acc[a][b][m][n] = (f32x4){0.f, 0.f, 0.f, 0.f};
    bf16x8 At[4][2], B0[2][2], B1[2][2];
    const char* cA = (const char*)g.A + (size_t)cur.pm * tstepA; const char* cB = (const char*)g.Bt + (size_t)cur.pn * tstepB;
    if constexpr (SP2) {
        PG8_STAGE(PG8_SB(0, 0), cB, voffB); PG8_STAGE(PG8_SB(0, 1), cB + hstepB, voffB); PG8_STAGE(PG8_SA(0, 0), cA, voffA); PG8_STAGE(PG8_SA(0, 1), cA + hstepA, voffA);
        if (wr == 1) PG8_BAR;
        PG8_WAIT_V(2); PG8_BAR;
        PG8_STAGE(PG8_SB(1, 0), cB + kstep, voffB); PG8_STAGE(PG8_SA(1, 0), cA + kstep, voffA); PG8_STAGE(PG8_SB(1, 1), cB + hstepB + kstep, voffB);
        PG8_WAIT_V(6); PG8_BAR;
    } else {
        PG8_STAGE(PG8_SB(0, 0), cB, voffB); PG8_STAGE(PG8_SA(0, 0), cA, voffA); PG8_STAGE(PG8_SB(0, 1), cB + hstepB, voffB); PG8_STAGE(PG8_SA(0, 1), cA + hstepA, voffA);
        if (wr == 1) PG8_BAR;
        PG8_WAIT_V(4); PG8_BAR;
        PG8_STAGE(PG8_SB(1, 0), cB + kstep, voffB); PG8_STAGE(PG8_SA(1, 0), cA + kstep, voffA); PG8_STAGE(PG8_SB(1, 1), cB + hstepB + kstep, voffB);
        PG8_WAIT_V(6); PG8_BAR;
    }
    for (;;) {
        const bool has_next = S.next(ui + 1, nxt);
        const char* nA = has_next ? (const char*)g.A + (size_t)nxt.pm * tstepA : cA; const char* nB = has_next ? (const char*)g.Bt + (size_t)nxt.pn * tstepB : cB;
        for (int t = 0; t < nt; t += 2) {
            const bool last = (t == nt - 2);
            if constexpr (Epi::HAS_MID) { if (t == 8 || t == 16) E.mid(acc, cur, t >> 3, wr, wc, fr, fq); }
            const char* a1 = cA + akoff<SEG>(t + 1);
            const char* a2 = last ? nA : cA + akoff<SEG>(t + 2); const char* b2 = last ? nB : cB + (size_t)(t + 2) * kstep;
            const char* a3 = a2 + kstep; const char* b3 = b2 + kstep;
            if constexpr (SP2) {
            PG8_LDB(B0, 0, 0); PG8_LDB(B1, 0, 1); PG8_SCHED; PG8_LDA(At, 0, 0); PG8_STAGE(PG8_SA(1, 1), a1 + hstepA, voffA);
            PG8_WAIT_V(8); PG8_WAIT_L(0); PG8_BAR; PG8_MMA(0, 0, At, B0); PG8_MMA(0, 1, At, B1); PG8_BAR; PG8_SCHED;
            PG8_LDA(At, 0, 1); PG8_STAGE(PG8_SB(0, 0), b2, voffB); PG8_STAGE(PG8_SB(0, 1), b2 + hstepB, voffB); PG8_STAGE(PG8_SA(0, 0), a2, voffA);
            PG8_WAIT_V(8); PG8_WAIT_L(0); PG8_BAR; PG8_MMA(1, 0, At, B0); PG8_MMA(1, 1, At, B1); PG8_BAR; PG8_SCHED;
            PG8_LDB(B0, 1, 0); PG8_LDB(B1, 1, 1); PG8_SCHED; PG8_LDA(At, 1, 0); PG8_STAGE(PG8_SA(0, 1), a2 + hstepA, voffA);
            PG8_WAIT_V(8); PG8_WAIT_L(0); PG8_BAR; PG8_MMA(0, 0, At, B0); PG8_MMA(0, 1, At, B1); PG8_BAR; PG8_SCHED;
            PG8_LDA(At, 1, 1); PG8_STAGE(PG8_SB(1, 0), b3, voffB); PG8_STAGE(PG8_SB(1, 1), b3 + hstepB, voffB); PG8_STAGE(PG8_SA(1, 0), a3, voffA);
            PG8_WAIT_V(8); PG8_WAIT_L(0); PG8_BAR; PG8_MMA(1, 0, At, B0); PG8_MMA(1, 1, At, B1); PG8_BAR; PG8_SCHED;
            } else {
            PG8_LDB(B0, 0, 0); PG8_SCHED; PG8_LDA(At, 0, 0); PG8_STAGE(PG8_SA(1, 1), a1 + hstepA, voffA);
            PG8_WAIT_L(8); PG8_BAR; PG8_WAIT_L(0); PG8_MMA(0, 0, At, B0); PG8_BAR; PG8_SCHED;
            PG8_LDB(B1, 0, 1); PG8_STAGE(PG8_SB(0, 0), b2, voffB);
            PG8_BAR; PG8_WAIT_L(0); PG8_MMA(0, 1, At, B1); PG8_BAR;
            PG8_LDA(At, 0, 1); PG8_STAGE(PG8_SA(0, 0), a2, voffA);
            PG8_BAR; PG8_WAIT_L(0); PG8_MMA(1, 0, At, B0); PG8_BAR; PG8_SCHED;
            PG8_STAGE(PG8_SB(0, 1), b2 + hstepB, voffB);
            PG8_WAIT_V(6); PG8_BAR; PG8_MMA(1, 1, At, B1); PG8_BAR;
            PG8_LDB(B0, 1, 0); PG8_SCHED; PG8_LDA(At, 1, 0); PG8_STAGE(PG8_SA(0, 1), a2 + hstepA, voffA);
            PG8_WAIT_L(8); PG8_BAR; PG8_WAIT_L(0); PG8_MMA(0, 0, At, B0); PG8_BAR; PG8_SCHED;
            PG8_LDB(B1, 1, 1); PG8_STAGE(PG8_SB(1, 0), b3, voffB);
            PG8_BAR; PG8_WAIT_L(0); PG8_MMA(0, 1, At, B1); PG8_BAR;
            PG8_LDA(At, 1, 1); PG8_STAGE(PG8_SA(1, 0), a3, voffA);
            PG8_BAR; PG8_WAIT_L(0); PG8_MMA(1, 0, At, B0); PG8_BAR; PG8_SCHED;
            PG8_STAGE(PG8_SB(1, 1), b3 + hstepB, voffB);
            PG8_WAIT_V(6); PG8_BAR; PG8_MMA(1, 1, At, B1); PG8_BAR;
            }
        }
        if constexpr (ALIGN_EPI) { if (wr == 0) PG8_BAR; }
        E(acc, cur, wr, wc, fr, fq);
        if (!has_next) break;
#pragma unroll
        for (int a = 0; a < 2; ++a)
#pragma unroll
            for (int b = 0; b < 2; ++b)
#pragma unroll
                for (int m = 0; m < 4; ++m)
#pragma unroll
                    for (int n = 0; n < 2; ++n) acc[a][b][m][n] = (f32x4){0.f, 0.f, 0.f, 0.f};
        cur = nxt; cA = nA; cB = nB; ++ui;
        if constexpr (ALIGN_EPI) { if (wr == 1) PG8_BAR; }
    }
    PG8_WAIT_V(0);
    if constexpr (!ALIGN_EPI) { if (wr == 0) PG8_BAR; }
    PG8_BAR;
#undef PG8_SA
#undef PG8_SB
#undef PG8_STAGE
#undef PG8_LDA
#undef PG8_LDB
#undef PG8_MMA
#undef PG8_WAIT_V
#undef PG8_WAIT_L
#undef PG8_BAR
#undef PG8_SCHED
}

struct EpiP {
    static constexpr bool PERM = true, HAS_MID = false;
    bf16_t* O; int ldc;
    DI void operator()(const Acc& acc, const Unit& u, int wr, int wc, int fr, int fq) const {
        const int row0 = u.pm * BM + wr * 64 + fr, col0 = u.pn * BM + wc * 32 + 8 * fq;
#pragma unroll
        for (int ai = 0; ai < 2; ++ai)
#pragma unroll
            for (int m = 0; m < 4; ++m) { bf16_t* rowp = O + (size_t)(row0 + ai * HALF + m * 16) * ldc + col0;
#pragma unroll
                for (int bj = 0; bj < 2; ++bj) { const f32x4 v0 = acc[ai][bj][m][0], v1 = acc[ai][bj][m][1];
                    u32x4 w; w.x = cvtpk(v0[0], v0[1]); w.y = cvtpk(v0[2], v0[3]); w.z = cvtpk(v1[0], v1[1]); w.w = cvtpk(v1[2], v1[3]);
                    *(u32x4*)(rowp + bj * HALF) = w; } }
    }
};
struct EpiKV {
    static constexpr bool PERM = false, HAS_MID = false;
    float* ok; float* ov; bf16_t* KB; bf16_t* VT;
    DI void operator()(const Acc& acc, const Unit& u, int wr, int wc, int fr, int fq) const {
        const int row0 = u.pm * BM + wr * 64 + fr, col0 = u.pn * BM + wc * 32 + 4 * fq;
        const bool isv = u.pn >= 2;
#pragma unroll
        for (int ai = 0; ai < 2; ++ai)
#pragma unroll
            for (int m = 0; m < 4; ++m) { const int r = row0 + ai * HALF + m * 16;
#pragma unroll
                for (int bj = 0; bj < 2; ++bj)
#pragma unroll
                    for (int n = 0; n < 2; ++n) { const f32x4 v = acc[ai][bj][m][n]; const int c = col0 + bj * HALF + n * 16;
                        if (!isv) { *(f32x4*)(ok + (size_t)r * 512 + c) = v; u32x2 w; w.x = cvtpk(v[0], v[1]); w.y = cvtpk(v[2], v[3]); *(u32x2*)(KB + (size_t)r * 512 + c) = w; }
                        else { const int cc = c - 512; *(f32x4*)(ov + (size_t)r * 512 + cc) = v;
                            const int b = r >> 8, mm = r & 255, h = cc >> 7, d = cc & 127; bf16_t* vt = VT + ((size_t)((b * 4 + h) * 128 + d)) * 256 + mm;
                            vt[0] = f2bf(v[0]); vt[256] = f2bf(v[1]); vt[512] = f2bf(v[2]); vt[768] = f2bf(v[3]); } } }
    }
};
struct EpiMerge {
    static constexpr bool PERM = true, HAS_MID = true;
    const bf16_t* P; bf16_t* O;
    DI void mid(Acc& acc, const Unit& u, int seg, int wr, int wc, int fr, int fq) const {
        const int row0 = opaque_v(u.pm * BM + wr * 64 + fr), col0 = opaque_v(u.pn * BM + wc * 32 + 8 * fq);
#pragma unroll
        for (int ai = 0; ai < 2; ++ai)
#pragma unroll
            for (int m = 0; m < 4; ++m) { const bf16_t* gp = P + (size_t)(row0 + ai * HALF + m * 16) * NP + PC_G + (seg - 1) * 1024 + col0;
#pragma unroll
                for (int bj = 0; bj < 2; ++bj) { const u32x4 ga = *(const u32x4*)(gp + bj * HALF), gb = *(const u32x4*)(gp + 1024 + bj * HALF);
                    float ra[8];
#pragma unroll
                    for (int q = 0; q < 4; ++q) { const float a0 = bflo(ga[q]), a1 = bfhi(ga[q]), b0 = bflo(gb[q]), b1 = bfhi(gb[q]);
                        ra[2 * q] = (1.f + fast_exp(-b0)) * fast_rcp(1.f + fast_exp(-a0)); ra[2 * q + 1] = (1.f + fast_exp(-b1)) * fast_rcp(1.f + fast_exp(-a1)); }
#pragma unroll
                    for (int n = 0; n < 2; ++n)
#pragma unroll
                        for (int j = 0; j < 4; ++j) acc[ai][bj][m][n][j] *= ra[4 * n + j];
                    asm volatile("" : "+v"(acc[ai][bj][m][0]), "+v"(acc[ai][bj][m][1]) :: "memory"); } }
    }
    DI void operator()(const Acc& acc, const Unit& u, int wr, int wc, int fr, int fq) const {
        const int row0 = opaque_v(u.pm * BM + wr * 64 + fr), col0 = opaque_v(u.pn * BM + wc * 32 + 8 * fq);
#pragma unroll
        for (int ai = 0; ai < 2; ++ai)
#pragma unroll
            for (int m = 0; m < 4; ++m) { const size_t r = (size_t)(row0 + ai * HALF + m * 16); const bf16_t* gp = P + r * NP + PC_G + 2048 + col0;
#pragma unroll
                for (int bj = 0; bj < 2; ++bj) { const u32x4 gm = *(const u32x4*)(gp + bj * HALF);
                    float s[8];
#pragma unroll
                    for (int q = 0; q < 4; ++q) { s[2 * q] = sigmoidf_(bflo(gm[q])); s[2 * q + 1] = sigmoidf_(bfhi(gm[q])); }
                    const f32x4 v0 = acc[ai][bj][m][0], v1 = acc[ai][bj][m][1];
                    u32x4 w; w.x = cvtpk(v0[0] * s[0], v0[1] * s[1]); w.y = cvtpk(v0[2] * s[2], v0[3] * s[3]); w.z = cvtpk(v1[0] * s[4], v1[1] * s[5]); w.w = cvtpk(v1[2] * s[6], v1[3] * s[7]);
                    *(u32x4*)(O + r * DM + col0 + bj * HALF) = w; } }
    }
};
struct EpiRes {
    static constexpr bool PERM = false, HAS_MID = false;
    const float* xp; const float* xs; float* out; bf16_t* xb; float* ssq;
    DI void operator()(const Acc& acc, const Unit& u, int wr, int wc, int fr, int fq) const {
        const int row0 = u.pm * BM + wr * 64 + fr, col0 = u.pn * BM + wc * 32 + 4 * fq;
        const float* base = (u.pm * BM < TP) ? xp : xs - (size_t)TP * DM;
#pragma unroll
        for (int ai = 0; ai < 2; ++ai)
#pragma unroll
            for (int m = 0; m < 4; ++m) { const size_t off = (size_t)(row0 + ai * HALF + m * 16) * DM + col0; float sq = 0.f;
#pragma unroll
                for (int bj = 0; bj < 2; ++bj)
#pragma unroll
                    for (int n = 0; n < 2; ++n) { const f32x4 bs = *(const f32x4*)(base + off + bj * HALF + n * 16); const f32x4 o = bs + acc[ai][bj][m][n];
                        sq += (o[0] * o[0] + o[1] * o[1]) + (o[2] * o[2] + o[3] * o[3]);
                        *(f32x4*)(out + off + bj * HALF + n * 16) = o;
                        if (xb) { u32x2 w; w.x = cvtpk(o[0], o[1]); w.y = cvtpk(o[2], o[3]); *(u32x2*)(xb + off + bj * HALF + n * 16) = w; } }
                sq += __shfl_xor(sq, 16); sq += __shfl_xor(sq, 32);
                if (fq == 0) ssq[(size_t)(row0 + ai * HALF + m * 16) * 16 + u.pn * 4 + wc] = sq; }
    }
};
struct EpiUp {
    static constexpr bool PERM = true, HAS_MID = false;
    const float* ssq; bf16_t* H;
    DI void operator()(const Acc& acc, const Unit& u, int wr, int wc, int fr, int fq) const {
        const int row0 = u.pm * BM + wr * 64 + fr, col0 = u.pn * HALF + wc * 32 + 8 * fq;
#pragma unroll
        for (int ai = 0; ai < 2; ++ai)
#pragma unroll
            for (int m = 0; m < 4; ++m) { const size_t r = (size_t)(row0 + ai * HALF + m * 16);
                const f32x4* sp = (const f32x4*)(ssq + r * 16); const f32x4 s0 = sp[0], s1 = sp[1], s2 = sp[2], s3 = sp[3];
                const float tot = ((s0[0] + s0[1]) + (s0[2] + s0[3])) + ((s1[0] + s1[1]) + (s1[2] + s1[3])) + ((s2[0] + s2[1]) + (s2[2] + s2[3])) + ((s3[0] + s3[1]) + (s3[2] + s3[3]));
                const float rstd = __builtin_amdgcn_rsqf(tot * (1.f / DM) + EPS);
                float hv[8];
#pragma unroll
                for (int n = 0; n < 2; ++n)
#pragma unroll
                    for (int j = 0; j < 4; ++j) { const float gt = acc[ai][0][m][n][j] * rstd, ut = acc[ai][1][m][n][j] * rstd; hv[4 * n + j] = siluf_(gt) * ut; }
                u32x4 w; w.x = cvtpk(hv[0], hv[1]); w.y = cvtpk(hv[2], hv[3]); w.z = cvtpk(hv[4], hv[5]); w.w = cvtpk(hv[6], hv[7]);
                *(u32x4*)(H + r * DFF + col0) = w; }
    }
};
}

constexpr size_t WS_CTL = 0, CTL_BYTES = 65536;
constexpr size_t WS_WIN = CTL_BYTES;
constexpr size_t WS_WKV = WS_WIN + (size_t)NP * DM * 2;
constexpr size_t WS_WBR = WS_WKV + (size_t)DM * DM * 2;
constexpr size_t WS_WO  = WS_WBR + (size_t)DM * 1536 * 2;
constexpr size_t WS_WUP = WS_WO + (size_t)DM * DM * 2;
constexpr size_t WS_WDN = WS_WUP + (size_t)2 * DFF * DM * 2;
constexpr size_t WS_P   = WS_WDN + (size_t)DM * DFF * 2;
constexpr size_t WS_X1B = WS_P;
constexpr size_t WS_H   = WS_P + (size_t)T * DM * 2;
constexpr size_t WS_R2  = WS_P + (size_t)T * NP * 2;
constexpr size_t WS_XN  = WS_R2;
constexpr size_t WS_MEMN = WS_XN + (size_t)T * DM * 2;
constexpr size_t WS_UBUF = WS_R2;
constexpr size_t WS_MG  = WS_R2;
constexpr size_t WS_GB  = WS_MEMN + (size_t)NB * MEMT * DM * 2;
constexpr size_t WS_SSQ1 = WS_GB + (size_t)T * 8 * 4;
constexpr size_t WS_SSQ2 = WS_SSQ1 + (size_t)T * 16 * 4;
constexpr size_t WS_EDL = WS_SSQ2 + (size_t)T * 16 * 4;
constexpr size_t WS_END = WS_EDL + 4096;
constexpr size_t OS_KB = 0;
constexpr size_t OS_VT = OS_KB + (size_t)2048 * 512 * 2;
constexpr size_t OS_REC = OS_VT + (size_t)2048 * 512 * 2;
constexpr int REC_W = 0, REC_QD = 16384, REC_KT = 32768, REC_QK = 49152, REC_BYTES = 57344;
static_assert(OS_REC + (size_t)1024 * REC_BYTES <= (size_t)TP * DM * 4, "scratch inside y_prompt");
static_assert(WS_END <= 326973984ull, "workspace map exceeds sum(inputs)");
constexpr size_t O_Y = 0, O_YS = (size_t)TP * DM, O_CAP = O_YS + (size_t)TS * DM, O_DCP = O_CAP + 8192, O_SP = O_DCP + 36864, O_MK = O_SP + 524288,
                 O_MV = O_MK + 1048576, O_CAS = O_MV + 1048576, O_DCS = O_CAS + 131072, O_SS = O_DCS + 589824, O_END = O_SS + 8388608;

constexpr int RING_BYTES = 131072, XTRA_OFF = RING_BYTES, XTRA_BYTES = 16384, MISC_OFF = XTRA_OFF + XTRA_BYTES, LDS_BYTES = MISC_OFF + 256;

#define XB_TMO      128
#define XB_XCNT(j)  (256  + 64 * (j))
#define XB_XSUB(j)  (1280 + 64 * (j))
#define XB_XGEN(j)  (2304 + 64 * (j))
#define XB_TOP      3328
#define XB_TOPGEN   3392
#define XCD_BAR_WORDS 3456
#define XB_SPIN_CAP (1u << 18)
DI unsigned xb_ld(unsigned* p)              { return __hip_atomic_load(p, __ATOMIC_RELAXED, __HIP_MEMORY_SCOPE_AGENT); }
DI unsigned xb_add(unsigned* p, unsigned v) { return __hip_atomic_fetch_add(p, v, __ATOMIC_RELAXED, __HIP_MEMORY_SCOPE_AGENT); }
DI unsigned xb_xcc_id() { return (unsigned)__builtin_amdgcn_s_getreg((3 << 11) | 20) & 0xFu; }
#define XB_SPIN(cond, bar) do { unsigned _sp = 0; while (cond) { __builtin_amdgcn_s_sleep(1); \
    if ((++_sp & 255u) == 0u) { if (xb_ld(&(bar)[XB_TMO])) break; if (_sp > XB_SPIN_CAP) { atomicAdd(&(bar)[XB_TMO], 1u); break; } } } } while (0)
struct XcdBarrier { unsigned* bar; unsigned x; volatile LAS unsigned* st; };
DI XcdBarrier xcd_barrier_post(unsigned* bar, volatile LAS unsigned* st) {
    XcdBarrier b; b.bar = bar; b.x = xb_xcc_id(); b.st = st;
    if (threadIdx.x == 0) (void)xb_add(&bar[XB_XCNT(b.x)], 1u);
    return b;
}
DI void xcd_barrier_complete(unsigned* bar, unsigned x, unsigned& nloc, unsigned& nx) {
    const unsigned G = gridDim.x * gridDim.y * gridDim.z;
    unsigned sum, cnt, mine, sp = 0u;
    for (;;) {
        sum = 0u; cnt = 0u; mine = 0u;
#pragma unroll
        for (unsigned j = 0; j < 16; ++j) { const unsigned c = xb_ld(&bar[XB_XCNT(j)]); sum += c; cnt += (c > 0u) ? 1u : 0u; mine = (j == x) ? c : mine; }
        if (sum == G) break;
        __builtin_amdgcn_s_sleep(1);
        if ((++sp & 255u) == 0u) { if (xb_ld(&bar[XB_TMO])) break; if (sp > XB_SPIN_CAP) { atomicAdd(&bar[XB_TMO], 1u); break; } }
    }
    nloc = mine > 0u ? mine : 1u; nx = cnt > 0u ? cnt : 1u;
}
DI void xcd_barrier(const XcdBarrier& b) {
    asm volatile("s_waitcnt vmcnt(0)" ::: "memory");
    __syncthreads();
    if (threadIdx.x == 0) {
        unsigned* bar = b.bar;
        __builtin_amdgcn_s_waitcnt(0);
        unsigned nloc = b.st[0], nx = b.st[1];
        if (nloc == 0u) { xcd_barrier_complete(bar, b.x, nloc, nx); b.st[0] = nloc; b.st[1] = nx; }
        const unsigned old = xb_add(&bar[XB_XSUB(b.x)], 1u);
        const unsigned gen = old / nloc;
        if (old + 1u == (gen + 1u) * nloc) {
            __builtin_amdgcn_fence(__ATOMIC_RELEASE, "agent");
            asm volatile("s_waitcnt vmcnt(0)" ::: "memory");
            const unsigned og = xb_add(&bar[XB_TOP], 1u);
            const unsigned tg = og / nx;
            if (og + 1u == (tg + 1u) * nx) xb_add(&bar[XB_TOPGEN], 1u);
            else XB_SPIN(xb_ld(&bar[XB_TOPGEN]) == tg, bar);
            __builtin_amdgcn_fence(__ATOMIC_ACQUIRE, "agent");
            xb_add(&bar[XB_XGEN(b.x)], 1u);
            asm volatile("s_waitcnt vmcnt(0)" ::: "memory");
        } else {
            XB_SPIN(xb_ld(&bar[XB_XGEN(b.x)]) == gen, bar);
            __builtin_amdgcn_fence(__ATOMIC_ACQUIRE, "agent");
            asm volatile("s_waitcnt vmcnt(0)" ::: "memory");
        }
    }
    __syncthreads();
}

struct Args { const float* in[23]; float* out; unsigned char* ws; int ph_lo, ph_hi; };
struct Frame {
    LAS unsigned char* lds; int tid, lane, wave, G, bid;
    const float* in[23]; float* out; unsigned char* ws;
};

DI void p0_transpose_item(const float* W, int K, int N, bf16_t* WT, int k0, int n0, int s0, const float* gain, LAS float* scr, int lane) {
#pragma unroll 8
    for (int i = 0; i < 32; ++i) { const int kk = 2 * i + (lane >> 5); float w = W[(size_t)(k0 + kk) * N + s0 + (lane & 31)]; if (gain) w *= gain[k0 + kk]; scr[kk * 33 + (lane & 31)] = w; }
    LDS_WAIT(); asm volatile("" ::: "memory");
    const int c = lane & 7;
#pragma unroll
    for (int j = 0; j < 4; ++j) { const int n = (lane >> 3) + 8 * j; const LAS float* s = scr + (8 * c) * 33 + n;
        u32x4 o; o.x = cvtpk(s[0 * 33], s[1 * 33]); o.y = cvtpk(s[2 * 33], s[3 * 33]); o.z = cvtpk(s[4 * 33], s[5 * 33]); o.w = cvtpk(s[6 * 33], s[7 * 33]);
        *(u32x4*)(WT + (size_t)(n0 + n) * K + k0 + 8 * c) = o; }
    LDS_WAIT(); asm volatile("" ::: "memory");
}
DI void p0_prologue(Frame& F) {
    unsigned char* ws = F.ws;
    LAS float* scr = (LAS float*)(F.lds + F.wave * 8704);
    LAS float* w8t = (LAS float*)(F.lds + 8 * 8704);
    const float* w_in = F.in[9];
    for (int i = F.tid; i < 8 * 1024; i += 512) { const int k = i >> 3, c = i & 7; w8t[c * 1024 + k] = w_in[(size_t)k * INW + 3584 + c]; }
    __syncthreads();
    const int gw = F.bid * 8 + F.wave, NGW = F.G * 8;
    constexpr int I_IN = 16 * (NP / 32), I_KV = 16 * 32, I_BR = 24 * 32, I_O = 16 * 32, I_UP = 16 * (2 * DFF / 32), I_DN = (DFF / 64) * 32;
    constexpr int NITEMS = I_IN + I_KV + I_BR + I_O + I_UP + I_DN;
    for (int it = gw; it < NITEMS; it += NGW) {
        int r = it;
        if (r < I_IN) { const int nb = r % (NP / 32), kb = r / (NP / 32), n0 = nb * 32, s0 = n0 < 3584 ? n0 : n0 + 8;
            p0_transpose_item(w_in, DM, INW, (bf16_t*)(ws + WS_WIN), kb * 64, n0, s0, nullptr, scr, F.lane); continue; } r -= I_IN;
        if (r < I_KV) { const int nb = r % 32, kb = r / 32; p0_transpose_item(F.in[16], DM, DM, (bf16_t*)(ws + WS_WKV), kb * 64, nb * 32, nb * 32, nullptr, scr, F.lane); continue; } r -= I_KV;
        if (r < I_BR) { const int nb = r % 32, kb = r / 32; p0_transpose_item(F.in[17], 1536, DM, (bf16_t*)(ws + WS_WBR), kb * 64, nb * 32, nb * 32, nullptr, scr, F.lane); continue; } r -= I_BR;
        if (r < I_O) { const int nb = r % 32, kb = r / 32; p0_transpose_item(F.in[18], DM, DM, (bf16_t*)(ws + WS_WO), kb * 64, nb * 32, nb * 32, nullptr, scr, F.lane); continue; } r -= I_O;
        if (r < I_UP) { const int nb = r % (2 * DFF / 32), kb = r / (2 * DFF / 32), n0 = nb * 32, pn = n0 >> 8, j = n0 & 255, s0 = j < 128 ? pn * 128 + j : DFF + pn * 128 + (j - 128);
            p0_transpose_item(F.in[20], DM, 2 * DFF, (bf16_t*)(ws + WS_WUP), kb * 64, n0, s0, F.in[19], scr, F.lane); continue; } r -= I_UP;
        { const int nb = r % 32, kb = r / 32; p0_transpose_item(F.in[21], DFF, DM, (bf16_t*)(ws + WS_WDN), kb * 64, nb * 32, nb * 32, nullptr, scr, F.lane); }
    }
    const float* nmix = F.in[8];
    f32x4 gm[4];
#pragma unroll
    for (int j = 0; j < 4; ++j) gm[j] = *((const f32x4*)nmix + F.lane + 64 * j);
    float* Gd = (float*)(ws + WS_GB); float* Bd = Gd + (size_t)T * 4;
    for (int m = gw; m < T; m += NGW) {
        const float* xrow = m < TP ? F.in[0] + (size_t)m * DM : F.in[1] + (size_t)(m - TP) * DM;
        f32x4 v[4]; float s2 = 0.f;
#pragma unroll
        for (int j = 0; j < 4; ++j) { v[j] = *((const f32x4*)xrow + F.lane + 64 * j); s2 += (v[j].x * v[j].x + v[j].y * v[j].y) + (v[j].z * v[j].z + v[j].w * v[j].w); }
        const float rstd = __builtin_amdgcn_rsqf(wave_sum(s2) * (1.f / DM) + EPS);
        u32x2* o8 = (u32x2*)(ws + WS_XN + (size_t)m * DM * 2) + F.lane;
        float dot[8];
#pragma unroll
        for (int c = 0; c < 8; ++c) dot[c] = 0.f;
#pragma unroll
        for (int j = 0; j < 4; ++j) { v[j] = v[j] * rstd * gm[j]; u32x2 w; w.x = cvtpk(v[j].x, v[j].y); w.y = cvtpk(v[j].z, v[j].w); o8[64 * j] = w;
#pragma unroll
            for (int c = 0; c < 8; ++c) { const f32x4 ww = *((const LAS f32x4*)(w8t + c * 1024) + F.lane + 64 * j); dot[c] += (v[j].x * ww.x + v[j].y * ww.y) + (v[j].z * ww.z + v[j].w * ww.w); } }
#pragma unroll
        for (int c = 0; c < 8; ++c) dot[c] = wave_sum(dot[c]);
        if (F.lane < 4) {
            float a_raw = dot[0], b_raw = dot[4];
            if (F.lane == 1) { a_raw = dot[1]; b_raw = dot[5]; } else if (F.lane == 2) { a_raw = dot[2]; b_raw = dot[6]; } else if (F.lane == 3) { a_raw = dot[3]; b_raw = dot[7]; }
            const float xa = a_raw + F.in[13][F.lane];
            const float sp = xa > 20.f ? xa : log1pf(expf(xa));
            Gd[(size_t)m * 4 + F.lane] = -expf(F.in[12][F.lane]) * sp;
            Bd[(size_t)m * 4 + F.lane] = 1.f / (1.f + expf(-b_raw));
        }
    }
    const float* nmem = F.in[15];
#pragma unroll
    for (int j = 0; j < 4; ++j) gm[j] = *((const f32x4*)nmem + F.lane + 64 * j);
    for (int m = gw; m < NB * MEMT; m += NGW) {
        const float* xrow = F.in[2] + (size_t)m * DM;
        f32x4 v[4]; float s2 = 0.f;
#pragma unroll
        for (int j = 0; j < 4; ++j) { v[j] = *((const f32x4*)xrow + F.lane + 64 * j); s2 += (v[j].x * v[j].x + v[j].y * v[j].y) + (v[j].z * v[j].z + v[j].w * v[j].w); }
        const float rstd = __builtin_amdgcn_rsqf(wave_sum(s2) * (1.f / DM) + EPS);
        u32x2* o8 = (u32x2*)(ws + WS_MEMN + (size_t)m * DM * 2) + F.lane;
#pragma unroll
        for (int j = 0; j < 4; ++j) { v[j] = v[j] * rstd * gm[j]; u32x2 w; w.x = cvtpk(v[j].x, v[j].y); w.y = cvtpk(v[j].z, v[j].w); o8[64 * j] = w; }
    }
}

DI void p8_final(Frame& F) {
    const int gw = F.bid * 8 + F.wave, NGW = F.G * 8;
    const float* nf = F.in[22]; const float* ssq = (const float*)(F.ws + WS_SSQ2);
    f32x4 gm[4];
#pragma unroll
    for (int j = 0; j < 4; ++j) gm[j] = *((const f32x4*)nf + F.lane + 64 * j);
    for (int m = gw; m < T; m += NGW) {
        float s = F.lane < 16 ? ssq[(size_t)m * 16 + F.lane] : 0.f;
        s += __shfl_xor(s, 1); s += __shfl_xor(s, 2); s += __shfl_xor(s, 4); s += __shfl_xor(s, 8);
        s = __shfl(s, 0);
        const float rstd = __builtin_amdgcn_rsqf(s * (1.f / DM) + EPS);
        f32x4* xr = (f32x4*)(F.out + (size_t)m * DM) + F.lane;
#pragma unroll
        for (int j = 0; j < 4; ++j) { f32x4 v = xr[64 * j]; xr[64 * j] = v * rstd * gm[j]; }
    }
}

DI int kperm(int a) { return (a & ~31) | (((a >> 2) & 3) << 3) | (((a >> 4) & 1) << 2) | (a & 3); }
DI int crow32(int reg, int hh) { return (reg & 3) + 8 * (reg >> 2) + 4 * hh; }
constexpr int D2_KB = 0, D2_QB = 17408, D2_AM = 34816, D2_REC = 51200, D2_UL = D2_REC + REC_BYTES  , D2_SM = D2_UL + 16384  ;
DI void p2_unit(Frame& F, int u) {
    const int b = u >> 7, c = (u >> 2) & 31, h = u & 3, ci = (b * 4 + h) * 32 + c;
    LAS unsigned char* L = F.lds;
    LAS float* sm = (LAS float*)(L + D2_SM);
    LAS float* s_dl = sm, *s_ed = sm + 64, *s_edl = sm + 128, *s_bt = sm + 192, *s_part = sm + 256, *s_rn = sm + 512, *s_bk = sm + 640;
    const bf16_t* P = (const bf16_t*)(F.ws + WS_P);
    const int tid = opaque_v(F.tid), w = opaque_s(F.wave), lane = tid & 63;
    const int tau = w >> 1, col = (w & 1) * 64 + lane;
    const size_t R0 = (size_t)b * SEQ + 64 * c;
    float val[64];
    if (w < 6) {
        const int pcol = (tau == 0 ? PC_V : (tau == 1 ? PC_K : PC_Q)) + h * 128 + col;
        const int chn = (tau == 0 ? 1024 : (tau == 1 ? 512 : 0)) + h * 128 + col;
        const float* cw = F.in[11];
        const float w0 = cw[chn], w1 = cw[1536 + chn], w2 = cw[2 * 1536 + chn], w3 = cw[3 * 1536 + chn];
        const bf16_t* px = P + (R0 - 3) * NP + pcol;
        float x0, x1, x2;
        if (c == 0) { x0 = 0.f; x1 = 0.f; x2 = 0.f; } else { x0 = bf2f(px[0]); x1 = bf2f(px[NP]); x2 = bf2f(px[2 * NP]); }
#pragma unroll
        for (int t = 0; t < 64; ++t) {
            const float x3 = bf2f(px[(size_t)(t + 3) * NP]);
            const float y = (w0 * x0 + w1 * x1) + (w2 * x2 + w3 * x3);
            val[t] = siluf_(y);
            x0 = x1; x1 = x2; x2 = x3;
        }
        if (c == 31) { float* o = F.out + O_DCP + (size_t)b * 3 * 1536 + chn; o[0] = x0; o[1536] = x1; o[2 * 1536] = x2; }
        if (tau != 0) {
            float r32[32];
#pragma unroll
            for (int t = 0; t < 32; ++t) { const float lo = val[t] * val[t], hi = val[t + 32] * val[t + 32]; const bool up = (lane & 32) != 0; const float keep = up ? hi : lo, send = up ? lo : hi; r32[t] = keep + __shfl_xor(send, 32); }
            float r16[16];
#pragma unroll
            for (int t = 0; t < 16; ++t) { const bool up = (lane & 16) != 0; const float keep = up ? r32[t + 16] : r32[t], send = up ? r32[t] : r32[t + 16]; r16[t] = keep + __shfl_xor(send, 16); }
            float r8[8];
#pragma unroll
            for (int t = 0; t < 8; ++t) { const bool up = (lane & 8) != 0; const float keep = up ? r16[t + 8] : r16[t], send = up ? r16[t] : r16[t + 8]; r8[t] = keep + __shfl_xor(send, 8); }
            float r4[4];
#pragma unroll
            for (int t = 0; t < 4; ++t) { const bool up = (lane & 4) != 0; const float keep = up ? r8[t + 4] : r8[t], send = up ? r8[t] : r8[t + 4]; r4[t] = keep + __shfl_xor(send, 4); }
            float r2[2];
#pragma unroll
            for (int t = 0; t < 2; ++t) { const bool up = (lane & 2) != 0; const float keep = up ? r4[t + 2] : r4[t], send = up ? r4[t] : r4[t + 2]; r2[t] = keep + __shfl_xor(send, 2); }
            { const bool up = (lane & 1) != 0; const float keep = up ? r2[1] : r2[0], send = up ? r2[0] : r2[1]; const float tot = keep + __shfl_xor(send, 1);
              s_part[((tau - 1) * 2 + (w & 1)) * 64 + lane] = tot; }
        }
    } else if (w == 6) {
        const float* Gd = (const float*)(F.ws + WS_GB); const float* Bd = Gd + (size_t)T * 4;
        const float g = Gd[(R0 + lane) * 4 + h], be = Bd[(R0 + lane) * 4 + h];
        float d = g;
#pragma unroll
        for (int o = 1; o < 64; o <<= 1) { const float t = __shfl_up(d, o); if (lane >= o) d += t; }
        const float dlast = __shfl(d, 63);
        s_dl[lane] = d; s_ed[lane] = __expf(d); s_edl[lane] = __expf(dlast - d); s_bt[lane] = be; s_bk[lane] = be * __expf(d);
        if (lane == 0) ((float*)(F.ws + WS_EDL))[ci] = __expf(dlast);
    }
    __syncthreads();
    if (tid < 128) { const int tt = tid >> 6, i = tid & 63; const float ss = s_part[(tt * 2) * 64 + i] + s_part[(tt * 2 + 1) * 64 + i];
        s_rn[tt * 64 + i] = __builtin_amdgcn_rsqf(ss + EPS) * (tt == 1 ? 0.08838834764831845f : 1.f); }
    __syncthreads();
    if (w >= 2 && w < 6) {
        LAS bf16_t* dst = (LAS bf16_t*)(L + (tau == 1 ? D2_KB : D2_QB));
#pragma unroll
        for (int t = 0; t < 64; ++t) { val[t] *= s_rn[(tau - 1) * 64 + t]; dst[t * 136 + col] = f2bf(val[t]); }
        if (tau == 1) {
            LAS bf16_t* kl = (LAS bf16_t*)(L + D2_REC + REC_KT);
#pragma unroll
            for (int i = 0; i < 64; ++i) kl[col * 64 + kperm(i)] = f2bf(val[i] * s_edl[i]);
        } else {
            LAS bf16_t* ql = (LAS bf16_t*)(L + D2_REC + REC_QD); const int pc = kperm(col);
#pragma unroll
            for (int i = 0; i < 64; ++i) ql[i * 128 + pc] = f2bf(val[i] * s_ed[i]);
        }
    }
    __syncthreads();
    if (w < 6) {
        const int mat = w / 3, tt = w % 3, ti = tt == 0 ? 0 : 1, tj = tt == 2 ? 1 : 0, r = lane & 31, hh = lane >> 5;
        const LAS unsigned char* ab = L + (mat == 0 ? D2_KB : D2_QB) + (32 * ti + r) * 272 + hh * 16;
        const LAS unsigned char* bb = L + D2_KB + (32 * tj + r) * 272 + hh * 16;
        f32x16 acc;
#pragma unroll
        for (int i = 0; i < 16; ++i) acc[i] = 0.f;
#pragma unroll
        for (int s = 0; s < 8; ++s) { const bf16x8 a = *(const LAS bf16x8*)(ab + s * 32), bq = *(const LAS bf16x8*)(bb + s * 32); acc = __builtin_amdgcn_mfma_f32_32x32x16_bf16(a, bq, acc, 0, 0, 0); }
        const int j = 32 * tj + r; const float dj = s_dl[j];
#pragma unroll
        for (int reg = 0; reg < 16; ++reg) { const int i = 32 * ti + crow32(reg, hh); const float di = s_dl[i];
            const float gam = (i >= j) ? __expf(di - dj) : 0.f;
            if (mat == 0) { ((LAS float*)(L + D2_AM))[i * 64 + j] = (i > j) ? s_bt[i] * acc[reg] * gam : 0.f; }
            else { ((LAS bf16_t*)(L + D2_REC + REC_QK))[i * 64 + kperm(j)] = f2bf(acc[reg] * gam); } }
    } else {
        const int t2 = tid - 384;
#pragma unroll
        for (int q = 0; q < 4; ++q) { const int idx = t2 + 128 * q, i = idx >> 4, c4 = idx & 15; *(LAS unsigned*)(L + D2_REC + REC_QK + (i * 64 + 32) * 2 + c4 * 4) = 0u; }
    }
    __syncthreads();
    if (w < 4) {
        const LAS f32x4* Am = (const LAS f32x4*)(L + D2_AM);
        const LAS float* rsc = (tau == 1) ? s_bk : s_bt;
#pragma unroll
        for (int i = 0; i < 64; ++i) {
            float a0 = val[i] * rsc[i];
            float a1 = 0.f, a2 = 0.f, a3 = 0.f;
#pragma unroll
            for (int j4 = 0; j4 < (i + 3) / 4; ++j4) { const f32x4 a = Am[i * 16 + j4];
                if (4 * j4 + 0 < i) a0 -= a.x * val[4 * j4 + 0];
                if (4 * j4 + 1 < i) a1 -= a.y * val[4 * j4 + 1];
                if (4 * j4 + 2 < i) a2 -= a.z * val[4 * j4 + 2];
                if (4 * j4 + 3 < i) a3 -= a.w * val[4 * j4 + 3];
                if ((j4 & 3) == 3) asm volatile("" ::: "memory"); }
            val[i] = (a0 + a1) + (a2 + a3);
            asm volatile("" ::: "memory");
        }
        if (tau == 0) {
            LAS bf16_t* ul = (LAS bf16_t*)(L + D2_UL);
#pragma unroll
            for (int i = 0; i < 64; ++i) ul[(((col >> 4) * 4 + (i >> 4)) * 64 + (((i & 15) >> 2) * 16 + (col & 15))) * 4 + (i & 3)] = f2bf(val[i]);
        } else {
            LAS bf16_t* wl = (LAS bf16_t*)(L + D2_REC + REC_W); const int pc = kperm(col);
#pragma unroll
            for (int i = 0; i < 64; ++i) wl[i * 128 + pc] = f2bf(-val[i]);
        }
    }
    __syncthreads();
    {
        unsigned char* rec = (unsigned char*)F.out + OS_REC + (size_t)ci * REC_BYTES;
#pragma unroll
        for (int i = 0; i < 7; ++i) { const int q = tid + 512 * i; *(u32x4*)(rec + q * 16) = *(const LAS u32x4*)(L + D2_REC + q * 16); }
        unsigned char* ub = F.ws + WS_UBUF + (size_t)ci * 16384;
#pragma unroll
        for (int i = 0; i < 2; ++i) { const int q = tid + 512 * i; *(u32x4*)(ub + q * 16) = *(const LAS u32x4*)(L + D2_UL + q * 16); }
    }
    __syncthreads();
}

constexpr int D3_LW = 0, D3_LQD = 17408, D3_LKT = 34816, D3_LQK = 53248, D3_BUF = 62464;
DI void d3_store_rec(LAS unsigned char* buf, const u32x4 (&rg)[7], int tid) {
#pragma unroll
    for (int i = 0; i < 7; ++i) { const int q = tid + 512 * i; int off;
        if (i < 2) off = D3_LW + (q >> 4) * 272 + (q & 15) * 16;
        else if (i < 4) { const int q2 = q - 1024; off = D3_LQD + (q2 >> 4) * 272 + (q2 & 15) * 16; }
        else if (i < 6) { const int q2 = q - 2048; off = D3_LKT + (q2 >> 3) * 144 + (q2 & 7) * 16; }
        else { const int q2 = q - 3072; off = D3_LQK + (q2 >> 3) * 144 + (q2 & 7) * 16; }
        *(LAS u32x4*)(buf + off) = rg[i]; }
}
DI bf16x8 pack8(const f32x4& a, const f32x4& b) { u32x4 p; p.x = cvtpk(a[0], a[1]); p.y = cvtpk(a[2], a[3]); p.z = cvtpk(b[0], b[1]); p.w = cvtpk(b[2], b[3]); return __builtin_bit_cast(bf16x8, p); }
DI void p3_scan(Frame& F, int bh) {
    const int b = bh >> 2, h = bh & 3, w = F.wave, lane = F.lane, fr = lane & 15, g = lane >> 4, n0 = 16 * w;
    LAS unsigned char* L = F.lds;
    LAS float* xpart = (LAS float*)(L + XTRA_OFF);
    LAS float* xrs = xpart + 512;
    bf16_t* P = (bf16_t*)(F.ws + WS_P);
    const unsigned char* rec0 = (const unsigned char*)F.out + OS_REC + (size_t)(bh * 32) * REC_BYTES;
    const unsigned char* ub0 = F.ws + WS_UBUF + (size_t)(bh * 32) * 16384;
    const float* edlp = (const float*)(F.ws + WS_EDL) + bh * 32;
    const float gn = F.in[14][n0 + fr];
    f32x4 Sacc[8]; bf16x8 Sb[4];
#pragma unroll
    for (int i = 0; i < 8; ++i) Sacc[i] = (f32x4){0.f, 0.f, 0.f, 0.f};
#pragma unroll
    for (int i = 0; i < 4; ++i) Sb[i] = (bf16x8){0, 0, 0, 0, 0, 0, 0, 0};
    u32x4 rg[7]; u32x2 uf[4];
#pragma unroll
    for (int i = 0; i < 7; ++i) rg[i] = *(const u32x4*)(rec0 + (F.tid + 512 * i) * 16);
    d3_store_rec(L, rg, F.tid);
    __syncthreads();
    for (int c = 0; c < 32; ++c) {
        LAS unsigned char* buf = L + (c & 1) * D3_BUF;
        if (c + 1 < 32) {
#pragma unroll
            for (int i = 0; i < 7; ++i) rg[i] = *(const u32x4*)(rec0 + (size_t)(c + 1) * REC_BYTES + (F.tid + 512 * i) * 16);
        }
#pragma unroll
        for (int mt = 0; mt < 4; ++mt) uf[mt] = *(const u32x2*)(ub0 + (size_t)c * 16384 + (((w * 4 + mt) * 64 + lane) * 4) * 2);
        const size_t zrow = (size_t)b * SEQ + 64 * c;
        bf16_t* zp = P + zrow * NP + PC_Z + h * 128 + n0 + fr;
        float zv[16];
#pragma unroll
        for (int mt = 0; mt < 4; ++mt)
#pragma unroll
            for (int r = 0; r < 4; ++r) zv[mt * 4 + r] = bf2f(zp[(size_t)(16 * mt + 4 * g + r) * NP]);
        const float edl = edlp[c];
        f32x4 VN[4], O[4];
#pragma unroll
        for (int mt = 0; mt < 4; ++mt) { VN[mt] = (f32x4){bflo(uf[mt].x), bfhi(uf[mt].x), bflo(uf[mt].y), bfhi(uf[mt].y)}; O[mt] = (f32x4){0.f, 0.f, 0.f, 0.f}; }
#pragma unroll
        for (int mt = 0; mt < 4; ++mt)
#pragma unroll
            for (int s = 0; s < 4; ++s) {
                const bf16x8 wf = *(const LAS bf16x8*)(buf + D3_LW + (16 * mt + fr) * 272 + (32 * s + 8 * g) * 2);
                const bf16x8 qf = *(const LAS bf16x8*)(buf + D3_LQD + (16 * mt + fr) * 272 + (32 * s + 8 * g) * 2);
                VN[mt] = __builtin_amdgcn_mfma_f32_16x16x32_bf16(wf, Sb[s], VN[mt], 0, 0, 0);
                O[mt] = __builtin_amdgcn_mfma_f32_16x16x32_bf16(qf, Sb[s], O[mt], 0, 0, 0);
            }
        bf16x8 VNb[2];
        VNb[0] = pack8(VN[0], VN[1]); VNb[1] = pack8(VN[2], VN[3]);
#pragma unroll
        for (int mt = 0; mt < 4; ++mt)
#pragma unroll
            for (int s = 0; s < 2; ++s) {
                const bf16x8 kf = *(const LAS bf16x8*)(buf + D3_LQK + (16 * mt + fr) * 144 + (32 * s + 8 * g) * 2);
                O[mt] = __builtin_amdgcn_mfma_f32_16x16x32_bf16(kf, VNb[s], O[mt], 0, 0, 0);
            }
#pragma unroll
        for (int m8 = 0; m8 < 8; ++m8) { Sacc[m8] = Sacc[m8] * edl;
#pragma unroll
            for (int s = 0; s < 2; ++s) {
                const bf16x8 kf = *(const LAS bf16x8*)(buf + D3_LKT + (16 * m8 + fr) * 144 + (32 * s + 8 * g) * 2);
                Sacc[m8] = __builtin_amdgcn_mfma_f32_16x16x32_bf16(kf, VNb[s], Sacc[m8], 0, 0, 0);
            } }
#pragma unroll
        for (int s = 0; s < 4; ++s) Sb[s] = pack8(Sacc[2 * s], Sacc[2 * s + 1]);
#pragma unroll
        for (int mt = 0; mt < 4; ++mt)
#pragma unroll
            for (int r = 0; r < 4; ++r) { float ss = O[mt][r] * O[mt][r]; ss += __shfl_xor(ss, 1); ss += __shfl_xor(ss, 2); ss += __shfl_xor(ss, 4); ss += __shfl_xor(ss, 8);
                if (fr == 0) xpart[w * 64 + 16 * mt + 4 * g + r] = ss; }
        __syncthreads();
        if (F.tid < 64) { float tot = 0.f;
#pragma unroll
            for (int ww = 0; ww < 8; ++ww) tot += xpart[ww * 64 + F.tid];
            xrs[F.tid] = __builtin_amdgcn_rsqf(tot * (1.f / 128.f) + EPS); }
        __syncthreads();
#pragma unroll
        for (int mt = 0; mt < 4; ++mt)
#pragma unroll
            for (int r = 0; r < 4; ++r) { const int tok = 16 * mt + 4 * g + r; const float y = O[mt][r] * xrs[tok] * gn * siluf_(zv[mt * 4 + r]);
                zp[(size_t)tok * NP] = f2bf(y); }
        if (c + 1 < 32) d3_store_rec(L + ((c + 1) & 1) * D3_BUF, rg, F.tid);
        __syncthreads();
    }
    float* so = F.out + O_SP + (size_t)bh * 128 * 128 + n0 + fr;
#pragma unroll
    for (int m8 = 0; m8 < 8; ++m8)
#pragma unroll
        for (int r = 0; r < 4; ++r) so[(size_t)(16 * m8 + 4 * g + r) * 128] = Sacc[m8][r];
}

DI void p3_conv_unit(Frame& F, int u) {
    bf16_t* P = (bf16_t*)(F.ws + WS_P);
    const int tid = opaque_v(F.tid);
    const int rg = tid >> 6, c0 = (tid & 63) * 8;
    const float* cw = F.in[10];
    float w0[8], w1[8], w2[8];
#pragma unroll
    for (int j = 0; j < 8; ++j) { w0[j] = cw[c0 + j]; w1[j] = cw[512 + c0 + j]; w2[j] = cw[1024 + c0 + j]; }
    float p0[8], p1[8];
    size_t row0; bool has_prev; const float* st = nullptr;
    if (u < 512) { row0 = (size_t)u * 32 + rg * 4; has_prev = (row0 % SEQ) != 0; }
    else { const int bb = (u - 512) * 8 + rg; row0 = (size_t)TP + bb * 4; has_prev = false; st = F.in[3] + (size_t)bb * 2 * 512 + c0; }
    if (st) {
#pragma unroll
        for (int j = 0; j < 8; ++j) { p0[j] = st[j]; p1[j] = st[512 + j]; }
    } else if (has_prev) {
        const u32x4 ca = *(const u32x4*)(P + (row0 - 2) * NP + PC_C + c0), ha = *(const u32x4*)(P + (row0 - 2) * NP + PC_H + c0);
        const u32x4 cb = *(const u32x4*)(P + (row0 - 1) * NP + PC_C + c0), hb = *(const u32x4*)(P + (row0 - 1) * NP + PC_H + c0);
#pragma unroll
        for (int q = 0; q < 4; ++q) { p0[2 * q] = bflo(ca[q]) * bflo(ha[q]); p0[2 * q + 1] = bfhi(ca[q]) * bfhi(ha[q]); p1[2 * q] = bflo(cb[q]) * bflo(hb[q]); p1[2 * q + 1] = bfhi(cb[q]) * bfhi(hb[q]); }
    } else {
#pragma unroll
        for (int j = 0; j < 8; ++j) { p0[j] = 0.f; p1[j] = 0.f; }
    }
#pragma unroll
    for (int i = 0; i < 4; ++i) {
        bf16_t* pr = P + (row0 + i) * NP + c0;
        const u32x4 bv = *(const u32x4*)(pr + PC_B), cv = *(const u32x4*)(pr + PC_C), hv = *(const u32x4*)(pr + PC_H);
        float cur[8], y[8];
#pragma unroll
        for (int q = 0; q < 4; ++q) { cur[2 * q] = bflo(cv[q]) * bflo(hv[q]); cur[2 * q + 1] = bfhi(cv[q]) * bfhi(hv[q]); }
#pragma unroll
        for (int q = 0; q < 4; ++q) {
            y[2 * q] = bflo(bv[q]) * (w0[2 * q] * p0[2 * q] + w1[2 * q] * p1[2 * q] + w2[2 * q] * cur[2 * q]);
            y[2 * q + 1] = bfhi(bv[q]) * (w0[2 * q + 1] * p0[2 * q + 1] + w1[2 * q + 1] * p1[2 * q + 1] + w2[2 * q + 1] * cur[2 * q + 1]); }
        u32x4 o; o.x = cvtpk(y[0], y[1]); o.y = cvtpk(y[2], y[3]); o.z = cvtpk(y[4], y[5]); o.w = cvtpk(y[6], y[7]);
        *(u32x4*)(pr + PC_B) = o;
        const size_t r = row0 + i;
        if (u < 512) { const int t = (int)(r % SEQ); if (t >= SEQ - 2) { float* o2 = F.out + O_CAP + ((size_t)(r / SEQ) * 2 + (t - (SEQ - 2))) * 512 + c0;
#pragma unroll
                for (int j = 0; j < 8; ++j) o2[j] = cur[j]; } }
        else if (i >= 2) { const int bb = (u - 512) * 8 + rg; float* o2 = F.out + O_CAS + ((size_t)bb * 2 + (i - 2)) * 512 + c0;
#pragma unroll
            for (int j = 0; j < 8; ++j) o2[j] = cur[j]; }
#pragma unroll
        for (int j = 0; j < 8; ++j) { p0[j] = p1[j]; p1[j] = cur[j]; }
    }
}

constexpr int AT_K = 0, AT_KSTR = 272, AT_VT = 256 * AT_KSTR  , AT_VSTR = 520;
DI void p3_attn_unit(Frame& F, int u) {
    const int tid = opaque_v(F.tid), w = opaque_s(F.wave), lane = tid & 63;
    const int b = u >> 5, h = (u >> 3) & 3, qb = u & 7, r = lane & 31, hh = lane >> 5;
    LAS unsigned char* L = F.lds;
    bf16_t* P = (bf16_t*)(F.ws + WS_P);
    const bf16_t* KB = (const bf16_t*)((const unsigned char*)F.out + OS_KB) + (size_t)b * 256 * 512 + h * 128;
    const bf16_t* VT = (const bf16_t*)((const unsigned char*)F.out + OS_VT) + (size_t)(b * 4 + h) * 128 * 256;
#pragma unroll
    for (int i = 0; i < 8; ++i) { const int q = tid + 512 * i; const int row = q >> 4, cp = q & 15;
        *(LAS u32x4*)(L + AT_K + row * AT_KSTR + cp * 16) = *(const u32x4*)(KB + (size_t)row * 512 + cp * 8); }
#pragma unroll
    for (int i = 0; i < 8; ++i) { const int q = tid + 512 * i; const int row = q >> 5, cp = q & 31;
        const u32x4 v = *(const u32x4*)(VT + (size_t)row * 256 + cp * 8);
        *(LAS u32x2*)(L + AT_VT + row * AT_VSTR + cp * 16) = (u32x2){v.x, v.y}; *(LAS u32x2*)(L + AT_VT + row * AT_VSTR + cp * 16 + 8) = (u32x2){v.z, v.w}; }
    const size_t qrow = (size_t)b * SEQ + qb * 256 + w * 32 + r;
    bf16_t* qp = P + qrow * NP + PC_XQ + h * 128;
    bf16x8 qf[8];
#pragma unroll
    for (int s = 0; s < 8; ++s) qf[s] = *(const bf16x8*)(qp + 16 * s + 8 * hh);
    __syncthreads();
    f32x16 S[8];
#pragma unroll
    for (int kt = 0; kt < 8; ++kt) {
#pragma unroll
        for (int i = 0; i < 16; ++i) S[kt][i] = 0.f;
#pragma unroll
        for (int s = 0; s < 8; ++s) { const bf16x8 kf = *(const LAS bf16x8*)(L + AT_K + (32 * kt + r) * AT_KSTR + (16 * s + 8 * hh) * 2);
            S[kt] = __builtin_amdgcn_mfma_f32_32x32x16_bf16(kf, qf[s], S[kt], 0, 0, 0); }
    }
    float mx = -3.0e38f;
#pragma unroll
    for (int kt = 0; kt < 8; ++kt)
#pragma unroll
        for (int i = 0; i < 16; ++i) mx = fmaxf(mx, S[kt][i]);
    mx = fmaxf(mx, __shfl_xor(mx, 32));
    const float sc = 0.08838834764831845f * 1.4426950408889634f;
    float sum = 0.f;
#pragma unroll
    for (int kt = 0; kt < 8; ++kt)
#pragma unroll
        for (int i = 0; i < 16; ++i) { const float p = __builtin_amdgcn_exp2f((S[kt][i] - mx) * sc); S[kt][i] = p; sum += p; }
    sum += __shfl_xor(sum, 32);
    const float inv = 1.f / sum;
    f32x16 O[4];
#pragma unroll
    for (int dt = 0; dt < 4; ++dt)
#pragma unroll
        for (int i = 0; i < 16; ++i) O[dt][i] = 0.f;
#pragma unroll
    for (int kt = 0; kt < 8; ++kt)
#pragma unroll
        for (int s = 0; s < 2; ++s) {
            u32x4 pk; pk.x = cvtpk(S[kt][8 * s + 0] * inv, S[kt][8 * s + 1] * inv); pk.y = cvtpk(S[kt][8 * s + 2] * inv, S[kt][8 * s + 3] * inv);
            pk.z = cvtpk(S[kt][8 * s + 4] * inv, S[kt][8 * s + 5] * inv); pk.w = cvtpk(S[kt][8 * s + 6] * inv, S[kt][8 * s + 7] * inv);
            const bf16x8 pf = __builtin_bit_cast(bf16x8, pk);
#pragma unroll
            for (int dt = 0; dt < 4; ++dt) {
                const LAS unsigned char* vp = L + AT_VT + (32 * dt + r) * AT_VSTR + (32 * kt + 16 * s + 4 * hh) * 2;
                const u32x2 lo = *(const LAS u32x2*)vp, hi = *(const LAS u32x2*)(vp + 16);
                const bf16x8 vf = __builtin_bit_cast(bf16x8, (u32x4){lo.x, lo.y, hi.x, hi.y});
                O[dt] = __builtin_amdgcn_mfma_f32_32x32x16_bf16(pf, vf, O[dt], 0, 0, 0);
            }
        }
    bf16_t* op = P + ((size_t)b * SEQ + qb * 256 + w * 32) * NP + PC_XQ + h * 128 + r;
#pragma unroll
    for (int dt = 0; dt < 4; ++dt)
#pragma unroll
        for (int i = 0; i < 16; ++i) op[(size_t)crow32(i, hh) * NP + 32 * dt] = f2bf(O[dt][i]);
    __syncthreads();
}

DI void p3_sattn_unit(Frame& F, int u) {
    const int tid = opaque_v(F.tid), w = opaque_s(F.wave), lane = tid & 63;
    const int b = u >> 2, h = u & 3, l5 = lane & 31, hh = lane >> 5;
    LAS float* sc = (LAS float*)F.lds;
    LAS float* red = sc + 1024;
    bf16_t* P = (bf16_t*)(F.ws + WS_P);
    bf16_t* qp = P + ((size_t)TP + b * 4) * NP + PC_XQ + h * 128;
    float q[4][4];
#pragma unroll
    for (int t = 0; t < 4; ++t) { const u32x2 v = *(const u32x2*)(qp + (size_t)t * NP + 4 * l5); q[t][0] = bflo(v.x); q[t][1] = bfhi(v.x); q[t][2] = bflo(v.y); q[t][3] = bfhi(v.y); }
    const float* kc = F.in[6] + ((size_t)b * 256 * 4 + h) * 128 + 4 * l5;
    const float* vc = F.in[7] + ((size_t)b * 256 * 4 + h) * 128 + 4 * l5;
    __syncthreads();
    f32x4 kv[16];
#pragma unroll
    for (int i = 0; i < 16; ++i) kv[i] = *(const f32x4*)(kc + (size_t)(32 * w + 2 * i + hh) * 512);
#pragma unroll
    for (int i = 0; i < 16; ++i) {
        float d[4];
#pragma unroll
        for (int t = 0; t < 4; ++t) { d[t] = (kv[i].x * q[t][0] + kv[i].y * q[t][1]) + (kv[i].z * q[t][2] + kv[i].w * q[t][3]);
            d[t] += __shfl_xor(d[t], 1); d[t] += __shfl_xor(d[t], 2); d[t] += __shfl_xor(d[t], 4); d[t] += __shfl_xor(d[t], 8); d[t] += __shfl_xor(d[t], 16); }
        if (l5 == 0) *(LAS f32x4*)(sc + (32 * w + 2 * i + hh) * 4) = (f32x4){d[0], d[1], d[2], d[3]};
    }
    f32x4 vv[16];
#pragma unroll
    for (int i = 0; i < 16; ++i) vv[i] = *(const f32x4*)(vc + (size_t)(32 * w + 16 * hh + i) * 512);
    __syncthreads();
    if (w < 4) {
        float s[4]; float mx = -3.0e38f;
#pragma unroll
        for (int j = 0; j < 4; ++j) { s[j] = sc[(lane + 64 * j) * 4 + w] * 0.08838834764831845f; mx = fmaxf(mx, s[j]); }
#pragma unroll
        for (int o = 1; o < 64; o <<= 1) mx = fmaxf(mx, __shfl_xor(mx, o));
        float sum = 0.f;
#pragma unroll
        for (int j = 0; j < 4; ++j) { s[j] = __expf(s[j] - mx); sum += s[j]; }
        sum = wave_sum(sum);
        const float inv = 1.f / sum;
#pragma unroll
        for (int j = 0; j < 4; ++j) sc[(lane + 64 * j) * 4 + w] = s[j] * inv;
    }
    __syncthreads();
    float acc[4][4];
#pragma unroll
    for (int t = 0; t < 4; ++t)
#pragma unroll
        for (int j = 0; j < 4; ++j) acc[t][j] = 0.f;
#pragma unroll
    for (int i = 0; i < 16; ++i) { const f32x4 p = *(const LAS f32x4*)(sc + (32 * w + 16 * hh + i) * 4);
#pragma unroll
        for (int t = 0; t < 4; ++t) { acc[t][0] += p[t] * vv[i].x; acc[t][1] += p[t] * vv[i].y; acc[t][2] += p[t] * vv[i].z; acc[t][3] += p[t] * vv[i].w; } }
#pragma unroll
    for (int t = 0; t < 4; ++t) *(LAS f32x4*)(red + ((2 * w + hh) * 4 + t) * 128 + 4 * l5) = (f32x4){acc[t][0], acc[t][1], acc[t][2], acc[t][3]};
    __syncthreads();
    { const int t = tid >> 7, d = tid & 127; float o = 0.f;
#pragma unroll
      for (int gq = 0; gq < 16; ++gq) o += red[(gq * 4 + t) * 128 + d];
      qp[(size_t)t * NP + d] = f2bf(o); }
}

DI void p3_sdn_unit(Frame& F, int u4) {
    const int tid = opaque_v(F.tid), lane = tid & 63, wh = opaque_s(F.wave) & 1;
    const int grp = tid >> 7, e = tid & 127, u = u4 * 4 + grp, b = u >> 2, h = u & 3;
    LAS float* base = (LAS float*)F.lds + grp * 1280;
    LAS float* s_k = base, *s_q = base + 512, *s_part = base + 1024, *s_tot = base + 1056;
    bf16_t* P = (bf16_t*)(F.ws + WS_P);
    const size_t row0 = (size_t)TP + b * 4;
    const float* cw = F.in[11]; const float* cs = F.in[4] + (size_t)b * 3 * 1536;
    float qv[4], kv[4], vv[4];
#pragma unroll
    for (int tau = 0; tau < 3; ++tau) {
        const int chn = tau * 512 + h * 128 + e;
        const float w0 = cw[chn], w1 = cw[1536 + chn], w2 = cw[2 * 1536 + chn], w3 = cw[3 * 1536 + chn];
        float x0 = cs[chn], x1 = cs[1536 + chn], x2 = cs[2 * 1536 + chn];
        float* dco = F.out + O_DCS + (size_t)b * 3 * 1536 + chn;
#pragma unroll
        for (int t = 0; t < 4; ++t) { const float x3 = bf2f(P[(row0 + t) * NP + PC_Q + chn]);
            const float y = siluf_((w0 * x0 + w1 * x1) + (w2 * x2 + w3 * x3));
            if (tau == 0) qv[t] = y; else if (tau == 1) kv[t] = y; else vv[t] = y;
            if (t >= 1) dco[(size_t)(t - 1) * 1536] = x3;
            x0 = x1; x1 = x2; x2 = x3; }
    }
    __syncthreads();
#pragma unroll
    for (int t = 0; t < 4; ++t) { const float a = wave_sum(qv[t] * qv[t]), c = wave_sum(kv[t] * kv[t]); if (lane == 0) { s_part[wh * 12 + t] = a; s_part[wh * 12 + 4 + t] = c; } }
    __syncthreads();
    if (e < 8) s_tot[e] = s_part[e] + s_part[12 + e];
    __syncthreads();
#pragma unroll
    for (int t = 0; t < 4; ++t) { qv[t] *= __builtin_amdgcn_rsqf(s_tot[t] + EPS) * 0.08838834764831845f; kv[t] *= __builtin_amdgcn_rsqf(s_tot[4 + t] + EPS);
        s_k[t * 128 + e] = kv[t]; s_q[t * 128 + e] = qv[t]; }
    const float* Gd = (const float*)(F.ws + WS_GB); const float* Bd = Gd + (size_t)T * 4;
    float s[128];
    const float* sp = F.in[5] + ((size_t)(b * 4 + h) * 128) * 128 + e;
#pragma unroll
    for (int j0 = 0; j0 < 128; j0 += 8) {
#pragma unroll
        for (int jj = 0; jj < 8; ++jj) s[j0 + jj] = sp[jj * 128];
        sp += 8 * 128; asm volatile("" : "+v"(sp)); }
    __syncthreads();
    float ov[4];
#pragma unroll
    for (int t = 0; t < 4; ++t) {
        const float a = __expf(Gd[(row0 + t) * 4 + h]), be = Bd[(row0 + t) * 4 + h];
        float r0 = 0.f, r1 = 0.f, r2 = 0.f, r3 = 0.f;
#pragma unroll
        for (int j4 = 0; j4 < 32; ++j4) { const f32x4 kk = *(const LAS f32x4*)(s_k + t * 128 + 4 * j4);
            s[4 * j4] *= a; s[4 * j4 + 1] *= a; s[4 * j4 + 2] *= a; s[4 * j4 + 3] *= a;
            r0 += kk.x * s[4 * j4]; r1 += kk.y * s[4 * j4 + 1]; r2 += kk.z * s[4 * j4 + 2]; r3 += kk.w * s[4 * j4 + 3];
            if ((j4 & 3) == 3) asm volatile("" : "+v"(r0), "+v"(r1), "+v"(r2), "+v"(r3) :: "memory"); }
        const float vn = be * (vv[t] - ((r0 + r1) + (r2 + r3)));
        float o0 = 0.f, o1 = 0.f, o2 = 0.f, o3 = 0.f;
        const LAS float* k2 = s_k + t * 128; asm volatile("" : "+v"(k2));
#pragma unroll
        for (int j4 = 0; j4 < 32; ++j4) { const f32x4 kk = *(const LAS f32x4*)(k2 + 4 * j4); const f32x4 qq = *(const LAS f32x4*)(s_q + t * 128 + 4 * j4);
            s[4 * j4] += kk.x * vn; s[4 * j4 + 1] += kk.y * vn; s[4 * j4 + 2] += kk.z * vn; s[4 * j4 + 3] += kk.w * vn;
            o0 += qq.x * s[4 * j4]; o1 += qq.y * s[4 * j4 + 1]; o2 += qq.z * s[4 * j4 + 2]; o3 += qq.w * s[4 * j4 + 3];
            if ((j4 & 3) == 3) asm volatile("" : "+v"(o0), "+v"(o1), "+v"(o2), "+v"(o3) :: "memory"); }
        ov[t] = (o0 + o1) + (o2 + o3);
    }
    float* so = F.out + O_SS + ((size_t)(b * 4 + h) * 128) * 128 + e;
#pragma unroll
    for (int j0 = 0; j0 < 128; j0 += 8) {
#pragma unroll
        for (int jj = 0; jj < 8; ++jj) so[jj * 128] = s[j0 + jj];
        so += 8 * 128; asm volatile("" : "+v"(so)); }
#pragma unroll
    for (int t = 0; t < 4; ++t) { const float a = wave_sum(ov[t] * ov[t]); if (lane == 0) s_part[wh * 12 + 8 + t] = a; }
    __syncthreads();
    if (e < 4) s_tot[8 + e] = s_part[8 + e] + s_part[12 + 8 + e];
    __syncthreads();
    const float gn = F.in[14][e];
#pragma unroll
    for (int t = 0; t < 4; ++t) { bf16_t* zp = P + (row0 + t) * NP + PC_Z + h * 128 + e; const float z = bf2f(*zp);
        *zp = f2bf(ov[t] * __builtin_amdgcn_rsqf(s_tot[8 + t] * (1.f / 128.f) + EPS) * gn * siluf_(z)); }
}

constexpr int N_PHASES = 9;
__global__ void __launch_bounds__(512, 2) fwd_kernel(Args args) {
    extern __shared__ __attribute__((aligned(16))) unsigned char lds_raw[];
    Frame F;
    F.lds = (LAS unsigned char*)lds_raw;
    F.tid = threadIdx.x; F.lane = F.tid & 63; F.wave = __builtin_amdgcn_readfirstlane(F.tid >> 6);
    F.G = gridDim.x; F.bid = blockIdx.x;
#pragma unroll
    for (int i = 0; i < 23; ++i) F.in[i] = args.in[i];
    F.out = args.out; F.ws = args.ws;
    volatile LAS unsigned* MISC = (volatile LAS unsigned*)(F.lds + MISC_OFF);
    if (F.tid < 64) MISC[F.tid] = 0u;
    __syncthreads();
    const int lo = args.ph_lo, hi = args.ph_hi;
    const bool one = (hi - lo) > 1;
    XcdBarrier bar; bar.bar = (unsigned*)(F.ws + WS_CTL); bar.x = 0; bar.st = nullptr;
    if (one) bar = xcd_barrier_post((unsigned*)(F.ws + WS_CTL), MISC + 8);
#ifndef PHASE_MASK
#define PHASE_MASK 0x1ff
#endif
#define IN(k) (((PHASE_MASK >> (k)) & 1) && lo <= (k) && (k) < hi)
#define SEAM(k) do { if (IN(k) && IN((k) + 1)) xcd_barrier(bar); } while (0)
    unsigned char* ws = F.ws;

    if (IN(0)) { p0_prologue(F); } SEAM(0);

    if (IN(1)) {
        { pg8::Gemm g{(const bf16_t*)(ws + WS_XN), (const bf16_t*)(ws + WS_WIN), T, NP, DM, DM}; pg8::StaticOrder S; S.init(T, NP, F.G, F.bid);
          pg8::EpiP E{(bf16_t*)(ws + WS_P), NP};
          pg8::gemm_phase<pg8::EpiP, false, true, true>(F.lds, g, S, E); }
        { pg8::Gemm g{(const bf16_t*)(ws + WS_MEMN), (const bf16_t*)(ws + WS_WKV), NB * MEMT, DM, DM, DM}; pg8::StaticOrder S;
          const int rot = ((T / 256) * (NP / 256)) % F.G;
          S.init(NB * MEMT, DM, F.G, (F.bid + F.G - (rot & ~7)) % F.G);
          pg8::EpiKV E{F.out + O_MK, F.out + O_MV, (bf16_t*)((unsigned char*)F.out + OS_KB), (bf16_t*)((unsigned char*)F.out + OS_VT)};
          pg8::gemm_phase<pg8::EpiKV, false, true, true>(F.lds, g, S, E); }
    } SEAM(1);

    if (IN(2)) { for (int u = F.bid; u < 1024; u += F.G) p2_unit(F, u); } SEAM(2);

    if (IN(3)) {
        if (F.bid < 32) p3_scan(F, F.bid);
        else {
            const int j0 = F.bid - 32, st = F.G - 32;
            for (int u = j0; u < 1424; u += st) {
                if (u < 256) p3_attn_unit(F, u);
                else if (u < 768) p3_sattn_unit(F, u - 256);
                else if (u < 896) p3_sdn_unit(F, u - 768);
                else p3_conv_unit(F, u - 896);
            }
        }
    } SEAM(3);

    if (IN(4)) {
        pg8::Gemm g{(const bf16_t*)(ws + WS_P), (const bf16_t*)(ws + WS_WBR), T, DM, 1536, NP}; pg8::StaticOrder S; S.init(T, DM, F.G, F.bid);
        pg8::EpiMerge E{(const bf16_t*)(ws + WS_P), (bf16_t*)(ws + WS_MG)};
        pg8::gemm_phase<pg8::EpiMerge, true, true, true>(F.lds, g, S, E);
    } SEAM(4);

    if (IN(5)) {
        pg8::Gemm g{(const bf16_t*)(ws + WS_MG), (const bf16_t*)(ws + WS_WO), T, DM, DM, DM}; pg8::StaticOrder S; S.init(T, DM, F.G, F.bid);
        pg8::EpiRes E{F.in[0], F.in[1], F.out, (bf16_t*)(ws + WS_X1B), (float*)(ws + WS_SSQ1)};
        pg8::gemm_phase<pg8::EpiRes, false, true, true>(F.lds, g, S, E);
    } SEAM(5);

    if (IN(6)) {
        pg8::Gemm g{(const bf16_t*)(ws + WS_X1B), (const bf16_t*)(ws + WS_WUP), T, 2 * DFF, DM, DM}; pg8::StaticOrder S; S.init(T, 2 * DFF, F.G, F.bid);
        pg8::EpiUp E{(const float*)(ws + WS_SSQ1), (bf16_t*)(ws + WS_H)};
        pg8::gemm_phase<pg8::EpiUp, false, true, true>(F.lds, g, S, E);
    } SEAM(6);

    if (IN(7)) {
        pg8::Gemm g{(const bf16_t*)(ws + WS_H), (const bf16_t*)(ws + WS_WDN), T, DM, DFF, DFF}; pg8::StaticOrder S; S.init(T, DM, F.G, F.bid);
        pg8::EpiRes E{F.out, F.out + (size_t)TP * DM, F.out, nullptr, (float*)(ws + WS_SSQ2)};
        pg8::gemm_phase<pg8::EpiRes, false, true, true>(F.lds, g, S, E);
    } SEAM(7);

    if (IN(8)) { p8_final(F); }
#undef IN
#undef SEAM
}

#ifndef MK_ONE_LAUNCH
#define MK_ONE_LAUNCH 1
#endif
extern "C" void kernel_launch(void* const* d_in, const int* in_sizes, int n_in, void* d_out, int out_size, void* d_ws, size_t ws_size, hipStream_t stream) {
    static int grid = 0;
    if (grid == 0) {
        if (n_in != 23 || out_size != (int)O_END || ws_size < WS_END) { fprintf(stderr, "kernel_launch: unexpected sizes n_in %d out %d ws %zu (need %zu)\n", n_in, out_size, ws_size, (size_t)WS_END); grid = -1; return; }
        int dev = 0, cus = 0, per_cu = 0;
        if (hipGetDevice(&dev) != hipSuccess || hipDeviceGetAttribute(&cus, hipDeviceAttributeMultiprocessorCount, dev) != hipSuccess) { grid = -1; return; }
        if (hipFuncSetAttribute((const void*)fwd_kernel, hipFuncAttributeMaxDynamicSharedMemorySize, LDS_BYTES) != hipSuccess) { fprintf(stderr, "kernel_launch: hipFuncSetAttribute failed\n"); grid = -1; return; }
        if (hipOccupancyMaxActiveBlocksPerMultiprocessor(&per_cu, (const void*)fwd_kernel, 512, LDS_BYTES) != hipSuccess || per_cu < 1) { fprintf(stderr, "kernel_launch: occupancy query says %d blocks per CU\n", per_cu); (void)hipGetLastError(); grid = -1; return; }
        grid = cus;
        if (grid <= 64) { fprintf(stderr, "kernel_launch: %d CUs is too few for this kernel's phase split\n", grid); grid = -1; return; }
    }
    if (grid < 0) return;
    Args a{};
    for (int i = 0; i < 23; ++i) a.in[i] = (const float*)d_in[i];
    a.out = (float*)d_out; a.ws = (unsigned char*)d_ws;
#if MK_ONE_LAUNCH
    (void)hipMemsetAsync((char*)d_ws + WS_CTL, 0, CTL_BYTES, stream);
    a.ph_lo = 0; a.ph_hi = N_PHASES;
    void* kargs[] = {&a};
    hipError_t e = hipLaunchCooperativeKernel((const void*)fwd_kernel, dim3(grid), dim3(512), kargs, LDS_BYTES, stream);
    if (e != hipSuccess) fprintf(stderr, "kernel_launch: cooperative launch failed: %s\n", hipGetErrorString(e));
#else
    for (int p = 0; p < N_PHASES; ++p) { a.ph_lo = p; a.ph_hi = p + 1; hipLaunchKernelGGL(fwd_kernel, dim3(grid), dim3(512), LDS_BYTES, stream, a); }
#endif
}
```

```cpp
#include <hip/hip_runtime.h>
#include <cstdio>
#include <cstdint>

#define LAS __attribute__((address_space(3)))
#define GAS __attribute__((address_space(1)))
typedef unsigned short bf16_t;
typedef short bf16x8 __attribute__((ext_vector_type(8)));
typedef short s16x4 __attribute__((ext_vector_type(4)));
typedef float f32x4 __attribute__((ext_vector_type(4)));
typedef float f32x2 __attribute__((ext_vector_type(2)));
typedef float f32x16 __attribute__((ext_vector_type(16)));
typedef unsigned u32x4 __attribute__((ext_vector_type(4)));
typedef unsigned u32x2 __attribute__((ext_vector_type(2)));
typedef __bf16 bf16x2_t __attribute__((ext_vector_type(2)));
#define DI __device__ __forceinline__

constexpr int DM = 1024, NB = 8, SEQ = 2048, SB = 128, SS = 4;
constexpr int TP = NB * SEQ;
constexpr int TS = SB * SS;
constexpr int T = TP + TS;
constexpr int NP = 7168;
constexpr int INW = 7176;
constexpr int DFF = 2816;
constexpr int MEMT = 256;
constexpr float EPS = 1e-6f;
constexpr int PC_B = 0, PC_C = 512, PC_H = 1024, PC_Q = 1536, PC_K = 2048, PC_V = 2560, PC_Z = 3072, PC_XQ = 3584, PC_G = 4096;

DI unsigned cvtpk(float lo, float hi) { f32x2 v = {lo, hi}; bf16x2_t b = __builtin_convertvector(v, bf16x2_t); return __builtin_bit_cast(unsigned, b); }
DI bf16_t f2bf(float f) { return (bf16_t)(cvtpk(f, 0.f) & 0xffffu); }
DI float bf2f(bf16_t h) { return __uint_as_float(((unsigned)h) << 16); }
DI float bflo(unsigned w) { return __uint_as_float(w << 16); }
DI float bfhi(unsigned w) { return __uint_as_float(w & 0xffff0000u); }
DI float fast_exp(float x) { return __builtin_amdgcn_exp2f(x * 1.4426950408889634f); }
DI float fast_rcp(float x) { return __builtin_amdgcn_rcpf(x); }
DI float sigmoidf_(float x) { return fast_rcp(1.f + fast_exp(-x)); }
DI float siluf_(float x) { return x * sigmoidf_(x); }
DI float wave_sum(float v) {
#pragma unroll
    for (int o = 1; o < 64; o <<= 1) v += __shfl_xor(v, o);
    return v;
}
DI int opaque_v(int x) { asm volatile("" : "+v"(x)); return x; }
DI int opaque_s(int x) { asm volatile("" : "+s"(x)); return x; }
#define LDS_WAIT() asm volatile("s_waitcnt lgkmcnt(0)" ::: "memory")
#define VM_WAIT() asm volatile("s_waitcnt vmcnt(0)" ::: "memory")

namespace pg8 {
constexpr int BM = 256, BK = 64, HALF = 128, HTB = HALF * BK * 2, STAGE_BYTES = 8 * HTB, NXCD = 8, WGM = 8;
__host__ __device__ __forceinline__ int lds_byte(int r, int c) { const int st = (r >> 4) * 2 + (c >> 5), rr = r & 15, cc = c & 31, ob = rr * 64 + cc * 2; return st * 1024 + (ob ^ (((ob >> 9) & 1) << 5)); }
__host__ __device__ __forceinline__ void stage_rc(int b, int& R, int& C) { const int st = b / 1024, sb = b % 1024, swz = sb ^ (((sb >> 9) & 1) << 5); R = (st >> 1) * 16 + swz / 64; C = (st & 1) * 32 + (swz % 64) / 2; }
__host__ __device__ __forceinline__ int perm32(int rho) { const int n = rho >> 4, i = rho & 15; return 8 * (i >> 2) + 4 * n + (i & 3); }

struct Unit { int pm, pn; };
struct Gemm { const bf16_t* A; const bf16_t* Bt; int M, N, K, lda; };

struct StaticOrder {
    int nM, nN, nwg, G, c;
    __device__ void init(int M, int N, int G_, int c_) { nM = M / BM; nN = N / BM; nwg = nM * nN; G = G_; c = c_; }
    __device__ bool next(int i, Unit& u) const {
        const long L = (long)i * G + c; if (L >= nwg) return false;
        int wgid = (int)L; { const int q = nwg / NXCD, r = nwg % NXCD, xcd = wgid % NXCD, off = wgid / NXCD; wgid = (xcd < r ? xcd * (q + 1) : r * (q + 1) + (xcd - r) * q) + off; }
        const int nig = WGM * nN, gid = wgid / nig, fm = gid * WGM, gsz = (nM - fm) < WGM ? (nM - fm) : WGM;
        u.pm = fm + ((wgid % nig) % gsz); u.pn = (wgid % nig) / gsz; return true;
    }
};

typedef f32x4 Acc[2][2][4][2];

template <bool SEG> DI size_t akoff(int t) { if (SEG) { const int s = t >> 3; return (size_t)(t & 7) * 128 + (s == 0 ? 0 : (s == 1 ? (size_t)PC_Z * 2 : (size_t)PC_XQ * 2)); } return (size_t)t * 128; }

template <class Epi, bool SEG, bool ALIGN_EPI, bool SP2>
DI void gemm_phase(LAS unsigned char* lds, const Gemm g, const StaticOrder& S, const Epi& E) {
    const int tid = threadIdx.x, wid = __builtin_amdgcn_readfirstlane(tid >> 6), lane = tid & 63, wr = wid >> 2, wc = wid & 3, fr = lane & 15, fq = lane >> 4;
    const int K = g.K, nt = K / BK, lda = g.lda;
    unsigned voffA[2], voffB[2];
#pragma unroll
    for (int i = 0; i < 2; ++i) { int R, C; stage_rc(tid * 16 + i * 8192, R, C); const int Rb = Epi::PERM ? ((R & ~31) + perm32(R & 31)) : R;
        voffA[i] = (unsigned)(R * lda + C) * 2u; voffB[i] = (unsigned)(Rb * K + C) * 2u; }
    const size_t kstep = (size_t)(BK * 2);
    const size_t hstepA = (size_t)HALF * lda * 2, tstepA = 2 * hstepA;
    const size_t hstepB = (size_t)HALF * K * 2, tstepB = 2 * hstepB;
    const unsigned ldsw = (unsigned)wid * 1024u;
    const int aoff = lds_byte(wr * 64 + fr, fq * 8), boff = lds_byte(wc * 32 + fr, fq * 8);
#define PG8_SA(b, h) (((b) * 2 + (h)) * HTB)
#define PG8_SB(b, h) ((4 + (b) * 2 + (h)) * HTB)
#define PG8_STAGE(bufoff, gbase, voff) do { _Pragma("unroll") for (int _i = 0; _i < 2; ++_i) \
        __builtin_amdgcn_global_load_lds((const unsigned*)((const char*)(gbase) + (voff)[_i]), (LAS unsigned*)(lds + (bufoff) + ldsw + _i * 8192), 16, 0, 0); } while (0)
#define PG8_LDA(dst, b, h) do { _Pragma("unroll") for (int m = 0; m < 4; ++m) _Pragma("unroll") for (int k = 0; k < 2; ++k) dst[m][k] = *(const LAS bf16x8*)(lds + PG8_SA(b, h) + aoff + m * 2048 + k * 1024); } while (0)
#define PG8_LDB(dst, b, h) do { _Pragma("unroll") for (int n = 0; n < 2; ++n) _Pragma("unroll") for (int k = 0; k < 2; ++k) dst[n][k] = *(const LAS bf16x8*)(lds + PG8_SB(b, h) + boff + n * 2048 + k * 1024); } while (0)
#define PG8_MMA(ai, bj, At, Bt) do { __builtin_amdgcn_s_setprio(1); _Pragma("unroll") for (int m = 0; m < 4; ++m) _Pragma("unroll") for (int n = 0; n < 2; ++n) _Pragma("unroll") for (int k = 0; k < 2; ++k) \
        acc[ai][bj][m][n] = __builtin_amdgcn_mfma_f32_16x16x32_bf16(Bt[n][k], At[m][k], acc[ai][bj][m][n], 0, 0, 0); __builtin_amdgcn_s_setprio(0); } while (0)
#define PG8_WAIT_V(n) asm volatile("s_waitcnt vmcnt(" #n ")" ::: "memory")
#define PG8_WAIT_L(n) asm volatile("s_waitcnt lgkmcnt(" #n ")" ::: "memory")
#define PG8_BAR __builtin_amdgcn_s_barrier()
#define PG8_SCHED __builtin_amdgcn_sched_barrier(0)
    Unit cur, nxt; int ui = 0;
    if (!S.next(0, cur)) return;
    Acc acc;
#pragma unroll
    for (int a = 0; a < 2; ++a)
#pragma unroll
        for (int b = 0; b < 2; ++b)
#pragma unroll
            for (int m = 0; m < 4; ++m)
#pragma unroll
                for (int n = 0; n < 2; ++n) acc[a][b][m][n] = (f32x4){0.f, 0.f, 0.f, 0.f};
    bf16x8 At[4][2], B0[2][2], B1[2][2];
    const char* cA = (const char*)g.A + (size_t)cur.pm * tstepA; const char* cB = (const char*)g.Bt + (size_t)cur.pn * tstepB;
    if constexpr (SP2) {
        PG8_STAGE(PG8_SB(0, 0), cB, voffB); PG8_STAGE(PG8_SB(0, 1), cB + hstepB, voffB); PG8_STAGE(PG8_SA(0, 0), cA, voffA); PG8_STAGE(PG8_SA(0, 1), cA + hstepA, voffA);
        if (wr == 1) PG8_BAR;
        PG8_WAIT_V(2); PG8_BAR;
        PG8_STAGE(PG8_SB(1, 0), cB + kstep, voffB); PG8_STAGE(PG8_SA(1, 0), cA + kstep, voffA); PG8_STAGE(PG8_SB(1, 1), cB + hstepB + kstep, voffB);
        PG8_WAIT_V(6); PG8_BAR;
    } else {
        PG8_STAGE(PG8_SB(0, 0), cB, voffB); PG8_STAGE(PG8_SA(0, 0), cA, voffA); PG8_STAGE(PG8_SB(0, 1), cB + hstepB, voffB); PG8_STAGE(PG8_SA(0, 1), cA + hstepA, voffA);
        if (wr == 1) PG8_BAR;
        PG8_WAIT_V(4); PG8_BAR;
        PG8_STAGE(PG8_SB(1, 0), cB + kstep, voffB); PG8_STAGE(PG8_SA(1, 0), cA + kstep, voffA); PG8_STAGE(PG8_SB(1, 1), cB + hstepB + kstep, voffB);
        PG8_WAIT_V(6); PG8_BAR;
    }
    for (;;) {
        const bool has_next = S.next(ui + 1, nxt);
        const char* nA = has_next ? (const char*)g.A + (size_t)nxt.pm * tstepA : cA; const char* nB = has_next ? (const char*)g.Bt + (size_t)nxt.pn * tstepB : cB;
        for (int t = 0; t < nt; t += 2) {
            const bool last = (t == nt - 2);
            if constexpr (Epi::HAS_MID) { if (t == 8 || t == 16) E.mid(acc, cur, t >> 3, wr, wc, fr, fq); }
            const char* a1 = cA + akoff<SEG>(t + 1);
            const char* a2 = last ? nA : cA + akoff<SEG>(t + 2); const char* b2 = last ? nB : cB + (size_t)(t + 2) * kstep;
            const char* a3 = a2 + kstep; const char* b3 = b2 + kstep;
            if constexpr (SP2) {
            PG8_LDB(B0, 0, 0); PG8_LDB(B1, 0, 1); PG8_SCHED; PG8_LDA(At, 0, 0); PG8_STAGE(PG8_SA(1, 1), a1 + hstepA, voffA);
            PG8_WAIT_V(8); PG8_WAIT_L(0); PG8_BAR; PG8_MMA(0, 0, At, B0); PG8_MMA(0, 1, At, B1); PG8_BAR; PG8_SCHED;
            PG8_LDA(At, 0, 1); PG8_STAGE(PG8_SB(0, 0), b2, voffB); PG8_STAGE(PG8_SB(0, 1), b2 + hstepB, voffB); PG8_STAGE(PG8_SA(0, 0), a2, voffA);
            PG8_WAIT_V(8); PG8_WAIT_L(0); PG8_BAR; PG8_MMA(1, 0, At, B0); PG8_MMA(1, 1, At, B1); PG8_BAR; PG8_SCHED;
            PG8_LDB(B0, 1, 0); PG8_LDB(B1, 1, 1); PG8_SCHED; PG8_LDA(At, 1, 0); PG8_STAGE(PG8_SA(0, 1), a2 + hstepA, voffA);
            PG8_WAIT_V(8); PG8_WAIT_L(0); PG8_BAR; PG8_MMA(0, 0, At, B0); PG8_MMA(0, 1, At, B1); PG8_BAR; PG8_SCHED;
            PG8_LDA(At, 1, 1); PG8_STAGE(PG8_SB(1, 0), b3, voffB); PG8_STAGE(PG8_SB(1, 1), b3 + hstepB, voffB); PG8_STAGE(PG8_SA(1, 0), a3, voffA);
            PG8_WAIT_V(8); PG8_WAIT_L(0); PG8_BAR; PG8_MMA(1, 0, At, B0); PG8_MMA(1, 1, At, B1); PG8_BAR; PG8_SCHED;
            } else {
            PG8_LDB(B0, 0, 0); PG8_SCHED; PG8_LDA(At, 0, 0); PG8_STAGE(PG8_SA(1, 1), a1 + hstepA, voffA);
            PG8_WAIT_L(8); PG8_BAR; PG8_WAIT_L(0); PG8_MMA(0, 0, At, B0); PG8_BAR; PG8_SCHED;
            PG8_LDB(B1, 0, 1); PG8_STAGE(PG8_SB(0, 0), b2, voffB);
            PG8_BAR; PG8_WAIT_L(0); PG8_MMA(0, 1, At, B1); PG8_BAR;
            PG8_LDA(At, 0, 1); PG8_STAGE(PG8_SA(0, 0), a2, voffA);
            PG8_BAR; PG8_WAIT_L(0); PG8_MMA(1, 0, At, B0); PG8_BAR; PG8_SCHED;
            PG8_STAGE(PG8_SB(0, 1), b2 + hstepB, voffB);
            PG8_WAIT_V(6); PG8_BAR; PG8_MMA(1, 1, At, B1); PG8_BAR;
            PG8_LDB(B0, 1, 0); PG8_SCHED; PG8_LDA(At, 1, 0); PG8_STAGE(PG8_SA(0, 1), a2 + hstepA, voffA);
            PG8_WAIT_L(8); PG8_BAR; PG8_WAIT_L(0); PG8_MMA(0, 0, At, B0); PG8_BAR; PG8_SCHED;
            PG8_LDB(B1, 1, 1); PG8_STAGE(PG8_SB(1, 0), b3, voffB);
            PG8_BAR; PG8_WAIT_L(0); PG8_MMA(0, 1, At, B1); PG8_BAR;
            PG8_LDA(At, 1, 1); PG8_STAGE(PG8_SA(1, 0), a3, voffA);
            PG8_BAR; PG8_WAIT_L(0); PG8_MMA(1, 0, At, B0); PG8_BAR; PG8_SCHED;
            PG8_STAGE(PG8_SB(1, 1), b3 + hstepB, voffB);
            PG8_WAIT_V(6); PG8_BAR; PG8_MMA(1, 1, At, B1); PG8_BAR;
            }
        }
        if constexpr (ALIGN_EPI) { if (wr == 0) PG8_BAR; }
        E(acc, cur, wr, wc, fr, fq);
        if (!has_next) break;
#pragma unroll
        for (int a = 0; a < 2; ++a)
#pragma unroll
            for (int b = 0; b < 2; ++b)
#pragma unroll
                for (int m = 0; m < 4; ++m)
#pragma unroll
                    for (int n = 0; n < 2; ++n) acc[a][b][m][n] = (f32x4){0.f, 0.f, 0.f, 0.f};
        cur = nxt; cA = nA; cB = nB; ++ui;
        if constexpr (ALIGN_EPI) { if (wr == 1) PG8_BAR; }
    }
    PG8_WAIT_V(0);
    if constexpr (!ALIGN_EPI) { if (wr == 0) PG8_BAR; }
    PG8_BAR;
#undef PG8_SA
#undef PG8_SB
#undef PG8_STAGE
#undef PG8_LDA
#undef PG8_LDB
#undef PG8_MMA
#undef PG8_WAIT_V
#undef PG8_WAIT_L
#undef PG8_BAR
#undef PG8_SCHED
}

struct EpiP {
    static constexpr bool PERM = true, HAS_MID = false;
    bf16_t* O; int ldc;
    DI void operator()(const Acc& acc, const Unit& u, int wr, int wc, int fr, int fq) const {
        const int row0 = u.pm * BM + wr * 64 + fr, col0 = u.pn * BM + wc * 32 + 8 * fq;
#pragma unroll
        for (int ai = 0; ai < 2; ++ai)
#pragma unroll
            for (int m = 0; m < 4; ++m) { bf16_t* rowp = O + (size_t)(row0 + ai * HALF + m * 16) * ldc + col0;
#pragma unroll
                for (int bj = 0; bj < 2; ++bj) { const f32x4 v0 = acc[ai][bj][m][0], v1 = acc[ai][bj][m][1];
                    u32x4 w; w.x = cvtpk(v0[0], v0[1]); w.y = cvtpk(v0[2], v0[3]); w.z = cvtpk(v1[0], v1[1]); w.w = cvtpk(v1[2], v1[3]);
                    *(u32x4*)(rowp + bj * HALF) = w; } }
    }
};
struct EpiKV {
    static constexpr bool PERM = false, HAS_MID = false;
    float* ok; float* ov; bf16_t* KB; bf16_t* VT;
    DI void operator()(const Acc& acc, const Unit& u, int wr, int wc, int fr, int fq) const {
        const int row0 = u.pm * BM + wr * 64 + fr, col0 = u.pn * BM + wc * 32 + 4 * fq;
        const bool isv = u.pn >= 2;
#pragma unroll
        for (int ai = 0; ai < 2; ++ai)
#pragma unroll
            for (int m = 0; m < 4; ++m) { const int r = row0 + ai * HALF + m * 16;
#pragma unroll
                for (int bj = 0; bj < 2; ++bj)
#pragma unroll
                    for (int n = 0; n < 2; ++n) { const f32x4 v = acc[ai][bj][m][n]; const int c = col0 + bj * HALF + n * 16;
                        if (!isv) { *(f32x4*)(ok + (size_t)r * 512 + c) = v; u32x2 w; w.x = cvtpk(v[0], v[1]); w.y = cvtpk(v[2], v[3]); *(u32x2*)(KB + (size_t)r * 512 + c) = w; }
                        else { const int cc = c - 512; *(f32x4*)(ov + (size_t)r * 512 + cc) = v;
                            const int b = r >> 8, mm = r & 255, h = cc >> 7, d = cc & 127; bf16_t* vt = VT + ((size_t)((b * 4 + h) * 128 + d)) * 256 + mm;
                            vt[0] = f2bf(v[0]); vt[256] = f2bf(v[1]); vt[512] = f2bf(v[2]); vt[768] = f2bf(v[3]); } } }
    }
};
struct EpiMerge {
    static constexpr bool PERM = true, HAS_MID = true;
    const bf16_t* P; bf16_t* O;
    DI void mid(Acc& acc, const Unit& u, int seg, int wr, int wc, int fr, int fq) const {
        const int row0 = opaque_v(u.pm * BM + wr * 64 + fr), col0 = opaque_v(u.pn * BM + wc * 32 + 8 * fq);
#pragma unroll
        for (int ai = 0; ai < 2; ++ai)
#pragma unroll
            for (int m = 0; m < 4; ++m) { const bf16_t* gp = P + (size_t)(row0 + ai * HALF + m * 16) * NP + PC_G + (seg - 1) * 1024 + col0;
#pragma unroll
                for (int bj = 0; bj < 2; ++bj) { const u32x4 ga = *(const u32x4*)(gp + bj * HALF), gb = *(const u32x4*)(gp + 1024 + bj * HALF);
                    float ra[8];
#pragma unroll
                    for (int q = 0; q < 4; ++q) { const float a0 = bflo(ga[q]), a1 = bfhi(ga[q]), b0 = bflo(gb[q]), b1 = bfhi(gb[q]);
                        ra[2 * q] = (1.f + fast_exp(-b0)) * fast_rcp(1.f + fast_exp(-a0)); ra[2 * q + 1] = (1.f + fast_exp(-b1)) * fast_rcp(1.f + fast_exp(-a1)); }
#pragma unroll
                    for (int n = 0; n < 2; ++n)
#pragma unroll
                        for (int j = 0; j < 4; ++j) acc[ai][bj][m][n][j] *= ra[4 * n + j];
                    asm volatile("" : "+v"(acc[ai][bj][m][0]), "+v"(acc[ai][bj][m][1]) :: "memory"); } }
    }
    DI void operator()(const Acc& acc, const Unit& u, int wr, int wc, int fr, int fq) const {
        const int row0 = opaque_v(u.pm * BM + wr * 64 + fr), col0 = opaque_v(u.pn * BM + wc * 32 + 8 * fq);
#pragma unroll
        for (int ai = 0; ai < 2; ++ai)
#pragma unroll
            for (int m = 0; m < 4; ++m) { const size_t r = (size_t)(row0 + ai * HALF + m * 16); const bf16_t* gp = P + r * NP + PC_G + 2048 + col0;
#pragma unroll
                for (int bj = 0; bj < 2; ++bj) { const u32x4 gm = *(const u32x4*)(gp + bj * HALF);
                    float s[8];
#pragma unroll
                    for (int q = 0; q < 4; ++q) { s[2 * q] = sigmoidf_(bflo(gm[q])); s[2 * q + 1] = sigmoidf_(bfhi(gm[q])); }
                    const f32x4 v0 = acc[ai][bj][m][0], v1 = acc[ai][bj][m][1];
                    u32x4 w; w.x = cvtpk(v0[0] * s[0], v0[1] * s[1]); w.y = cvtpk(v0[2] * s[2], v0[3] * s[3]); w.z = cvtpk(v1[0] * s[4], v1[1] * s[5]); w.w = cvtpk(v1[2] * s[6], v1[3] * s[7]);
                    *(u32x4*)(O + r * DM + col0 + bj * HALF) = w; } }
    }
};
struct EpiRes {
    static constexpr bool PERM = false, HAS_MID = false;
    const float* xp; const float* xs; float* out; bf16_t* xb; float* ssq;
    DI void operator()(const Acc& acc, const Unit& u, int wr, int wc, int fr, int fq) const {
        const int row0 = u.pm * BM + wr * 64 + fr, col0 = u.pn * BM + wc * 32 + 4 * fq;
        const float* base = (u.pm * BM < TP) ? xp : xs - (size_t)TP * DM;
#pragma unroll
        for (int ai = 0; ai < 2; ++ai)
#pragma unroll
            for (int m = 0; m < 4; ++m) { const size_t off = (size_t)(row0 + ai * HALF + m * 16) * DM + col0; float sq = 0.f;
#pragma unroll
                for (int bj = 0; bj < 2; ++bj)
#pragma unroll
                    for (int n = 0; n < 2; ++n) { const f32x4 bs = *(const f32x4*)(base + off + bj * HALF + n * 16); const f32x4 o = bs + acc[ai][bj][m][n];
                        sq += (o[0] * o[0] + o[1] * o[1]) + (o[2] * o[2] + o[3] * o[3]);
                        *(f32x4*)(out + off + bj * HALF + n * 16) = o;
                        if (xb) { u32x2 w; w.x = cvtpk(o[0], o[1]); w.y = cvtpk(o[2], o[3]); *(u32x2*)(xb + off + bj * HALF + n * 16) = w; } }
                sq += __shfl_xor(sq, 16); sq += __shfl_xor(sq, 32);
                if (fq == 0) ssq[(size_t)(row0 + ai * HALF + m * 16) * 16 + u.pn * 4 + wc] = sq; }
    }
};
struct EpiUp {
    static constexpr bool PERM = true, HAS_MID = false;
    const float* ssq; bf16_t* H;
    DI void operator()(const Acc& acc, const Unit& u, int wr, int wc, int fr, int fq) const {
        const int row0 = u.pm * BM + wr * 64 + fr, col0 = u.pn * HALF + wc * 32 + 8 * fq;
#pragma unroll
        for (int ai = 0; ai < 2; ++ai)
#pragma unroll
            for (int m = 0; m < 4; ++m) { const size_t r = (size_t)(row0 + ai * HALF + m * 16);
                const f32x4* sp = (const f32x4*)(ssq + r * 16); const f32x4 s0 = sp[0], s1 = sp[1], s2 = sp[2], s3 = sp[3];
                const float tot = ((s0[0] + s0[1]) + (s0[2] + s0[3])) + ((s1[0] + s1[1]) + (s1[2] + s1[3])) + ((s2[0] + s2[1]) + (s2[2] + s2[3])) + ((s3[0] + s3[1]) + (s3[2] + s3[3]));
                const float rstd = __builtin_amdgcn_rsqf(tot * (1.f / DM) + EPS);
                float hv[8];
#pragma unroll
                for (int n = 0; n < 2; ++n)
#pragma unroll
                    for (int j = 0; j < 4; ++j) { const float gt = acc[ai][0][m][n][j] * rstd, ut = acc[ai][1][m][n][j] * rstd; hv[4 * n + j] = siluf_(gt) * ut; }
                u32x4 w; w.x = cvtpk(hv[0], hv[1]); w.y = cvtpk(hv[2], hv[3]); w.z = cvtpk(hv[4], hv[5]); w.w = cvtpk(hv[6], hv[7]);
                *(u32x4*)(H + r * DFF + col0) = w; }
    }
};
}

constexpr size_t WS_CTL = 0, CTL_BYTES = 65536;
constexpr size_t WS_WIN = CTL_BYTES;
constexpr size_t WS_WKV = WS_WIN + (size_t)NP * DM * 2;
constexpr size_t WS_WBR = WS_WKV + (size_t)DM * DM * 2;
constexpr size_t WS_WO  = WS_WBR + (size_t)DM * 1536 * 2;
constexpr size_t WS_WUP = WS_WO + (size_t)DM * DM * 2;
constexpr size_t WS_WDN = WS_WUP + (size_t)2 * DFF * DM * 2;
constexpr size_t WS_P   = WS_WDN + (size_t)DM * DFF * 2;
constexpr size_t WS_X1B = WS_P;
constexpr size_t WS_H   = WS_P + (size_t)T * DM * 2;
constexpr size_t WS_X1  = WS_H + (size_t)T * DFF * 2;
constexpr size_t WS_R2  = WS_P + (size_t)T * NP * 2;
constexpr size_t WS_XN  = WS_R2;
constexpr size_t WS_MEMN = WS_XN + (size_t)T * DM * 2;
constexpr size_t WS_UBUF = WS_R2;
constexpr size_t WS_MG  = WS_R2;
constexpr size_t WS_GB  = WS_MEMN + (size_t)NB * MEMT * DM * 2;
constexpr size_t WS_SSQ1 = WS_GB + (size_t)T * 8 * 4;
constexpr size_t WS_SSQ2 = WS_SSQ1 + (size_t)T * 16 * 4;
constexpr size_t WS_EDL = WS_SSQ2 + (size_t)T * 16 * 4;
constexpr size_t WS_END = WS_EDL + 4096;
constexpr size_t OS_KB = 0;
constexpr size_t OS_VT = OS_KB + (size_t)2048 * 512 * 2;
constexpr size_t OS_REC = OS_VT + (size_t)2048 * 512 * 2;
constexpr int REC_W = 0, REC_QD = 16384, REC_KT = 32768, REC_QK = 49152, REC_BYTES = 57344;
static_assert(OS_REC + (size_t)1024 * REC_BYTES <= (size_t)TP * DM * 4, "scratch inside y_prompt");
static_assert(WS_END <= 326973984ull, "workspace map exceeds sum(inputs)");
constexpr size_t O_Y = 0, O_YS = (size_t)TP * DM, O_CAP = O_YS + (size_t)TS * DM, O_DCP = O_CAP + 8192, O_SP = O_DCP + 36864, O_MK = O_SP + 524288,
                 O_MV = O_MK + 1048576, O_CAS = O_MV + 1048576, O_DCS = O_CAS + 131072, O_SS = O_DCS + 589824, O_END = O_SS + 8388608;

constexpr int RING_BYTES = 131072, XTRA_OFF = RING_BYTES, MISC_OFF = 159232, LDS_BYTES = MISC_OFF + 256;

#define XB_TMO      128
#define XB_XCNT(j)  (256  + 64 * (j))
#define XB_XSUB(j)  (1280 + 64 * (j))
#define XB_XGEN(j)  (2304 + 64 * (j))
#define XB_TOP      3328
#define XB_TOPGEN   3392
#define XCD_BAR_WORDS 3456
#define XB_SPIN_CAP (1u << 18)
DI unsigned xb_ld(unsigned* p)              { return __hip_atomic_load(p, __ATOMIC_RELAXED, __HIP_MEMORY_SCOPE_AGENT); }
DI unsigned xb_add(unsigned* p, unsigned v) { return __hip_atomic_fetch_add(p, v, __ATOMIC_RELAXED, __HIP_MEMORY_SCOPE_AGENT); }
DI unsigned xb_xcc_id() { return (unsigned)__builtin_amdgcn_s_getreg((3 << 11) | 20) & 0xFu; }
#define XB_SPIN(cond, bar) do { unsigned _sp = 0; while (cond) { __builtin_amdgcn_s_sleep(1); \
    if ((++_sp & 255u) == 0u) { if (xb_ld(&(bar)[XB_TMO])) break; if (_sp > XB_SPIN_CAP) { atomicAdd(&(bar)[XB_TMO], 1u); break; } } } } while (0)
struct XcdBarrier { unsigned* bar; unsigned x; volatile LAS unsigned* st; };
DI XcdBarrier xcd_barrier_post(unsigned* bar, volatile LAS unsigned* st) {
    XcdBarrier b; b.bar = bar; b.x = xb_xcc_id(); b.st = st;
    if (threadIdx.x == 0) (void)xb_add(&bar[XB_XCNT(b.x)], 1u);
    return b;
}
DI void xcd_barrier_complete(unsigned* bar, unsigned x, unsigned& nloc, unsigned& nx) {
    const unsigned G = gridDim.x * gridDim.y * gridDim.z;
    unsigned sum, cnt, mine, sp = 0u;
    for (;;) {
        sum = 0u; cnt = 0u; mine = 0u;
#pragma unroll
        for (unsigned j = 0; j < 16; ++j) { const unsigned c = xb_ld(&bar[XB_XCNT(j)]); sum += c; cnt += (c > 0u) ? 1u : 0u; mine = (j == x) ? c : mine; }
        if (sum == G) break;
        __builtin_amdgcn_s_sleep(1);
        if ((++sp & 255u) == 0u) { if (xb_ld(&bar[XB_TMO])) break; if (sp > XB_SPIN_CAP) { atomicAdd(&bar[XB_TMO], 1u); break; } }
    }
    nloc = mine > 0u ? mine : 1u; nx = cnt > 0u ? cnt : 1u;
}
DI void xcd_barrier(const XcdBarrier& b) {
    asm volatile("s_waitcnt vmcnt(0)" ::: "memory");
    __syncthreads();
    if (threadIdx.x == 0) {
        unsigned* bar = b.bar;
        __builtin_amdgcn_s_waitcnt(0);
        unsigned nloc = b.st[0], nx = b.st[1];
        if (nloc == 0u) { xcd_barrier_complete(bar, b.x, nloc, nx); b.st[0] = nloc; b.st[1] = nx; }
        const unsigned old = xb_add(&bar[XB_XSUB(b.x)], 1u);
        const unsigned gen = old / nloc;
        if (old + 1u == (gen + 1u) * nloc) {
            __builtin_amdgcn_fence(__ATOMIC_RELEASE, "agent");
            asm volatile("s_waitcnt vmcnt(0)" ::: "memory");
            const unsigned og = xb_add(&bar[XB_TOP], 1u);
            const unsigned tg = og / nx;
            if (og + 1u == (tg + 1u) * nx) xb_add(&bar[XB_TOPGEN], 1u);
            else XB_SPIN(xb_ld(&bar[XB_TOPGEN]) == tg, bar);
            __builtin_amdgcn_fence(__ATOMIC_ACQUIRE, "agent");
            xb_add(&bar[XB_XGEN(b.x)], 1u);
            asm volatile("s_waitcnt vmcnt(0)" ::: "memory");
        } else {
            XB_SPIN(xb_ld(&bar[XB_XGEN(b.x)]) == gen, bar);
            __builtin_amdgcn_fence(__ATOMIC_ACQUIRE, "agent");
            asm volatile("s_waitcnt vmcnt(0)" ::: "memory");
        }
    }
    __syncthreads();
}

struct Args { const float* in[23]; float* out; unsigned char* ws; int ph_lo, ph_hi, sub, pad; };
struct Frame {
    LAS unsigned char* lds; int tid, lane, wave, G, bid;
    const float* in[23]; float* out; unsigned char* ws;
};

DI void p0_transpose_item(const float* W, int K, int N, bf16_t* WT, int k0, int n0, int s0, const float* gain, LAS float* scr, int lane) {
#pragma unroll 8
    for (int i = 0; i < 32; ++i) { const int kk = 2 * i + (lane >> 5); float w = W[(size_t)(k0 + kk) * N + s0 + (lane & 31)]; if (gain) w *= gain[k0 + kk]; scr[kk * 33 + (lane & 31)] = w; }
    LDS_WAIT(); asm volatile("" ::: "memory");
    const int c = lane & 7;
#pragma unroll
    for (int j = 0; j < 4; ++j) { const int n = (lane >> 3) + 8 * j; const LAS float* s = scr + (8 * c) * 33 + n;
        u32x4 o; o.x = cvtpk(s[0 * 33], s[1 * 33]); o.y = cvtpk(s[2 * 33], s[3 * 33]); o.z = cvtpk(s[4 * 33], s[5 * 33]); o.w = cvtpk(s[6 * 33], s[7 * 33]);
        *(u32x4*)(WT + (size_t)(n0 + n) * K + k0 + 8 * c) = o; }
    LDS_WAIT(); asm volatile("" ::: "memory");
}
DI void p0_prologue(Frame& F) {
    unsigned char* ws = F.ws;
    LAS float* scr = (LAS float*)(F.lds + F.wave * 8704);
    LAS float* w8t = (LAS float*)(F.lds + 8 * 8704);
    const float* w_in = F.in[9];
    for (int i = F.tid; i < 8 * 1024; i += 512) { const int k = i >> 3, c = i & 7; w8t[c * 1024 + k] = w_in[(size_t)k * INW + 3584 + c]; }
    __syncthreads();
    const int gw = F.bid * 8 + F.wave, NGW = F.G * 8;
    constexpr int I_IN = 16 * (NP / 32), I_KV = 16 * 32, I_BR = 24 * 32, I_O = 16 * 32, I_UP = 16 * (2 * DFF / 32), I_DN = (DFF / 64) * 32;
    constexpr int NITEMS = I_IN + I_KV + I_BR + I_O + I_UP + I_DN;
    for (int it = gw; it < NITEMS; it += NGW) {
        int r = it;
        if (r < I_IN) { const int nb = r % (NP / 32), kb = r / (NP / 32), n0 = nb * 32, s0 = n0 < 3584 ? n0 : n0 + 8;
            p0_transpose_item(w_in, DM, INW, (bf16_t*)(ws + WS_WIN), kb * 64, n0, s0, nullptr, scr, F.lane); continue; } r -= I_IN;
        if (r < I_KV) { const int nb = r % 32, kb = r / 32; p0_transpose_item(F.in[16], DM, DM, (bf16_t*)(ws + WS_WKV), kb * 64, nb * 32, nb * 32, nullptr, scr, F.lane); continue; } r -= I_KV;
        if (r < I_BR) { const int nb = r % 32, kb = r / 32; p0_transpose_item(F.in[17], 1536, DM, (bf16_t*)(ws + WS_WBR), kb * 64, nb * 32, nb * 32, nullptr, scr, F.lane); continue; } r -= I_BR;
        if (r < I_O) { const int nb = r % 32, kb = r / 32; p0_transpose_item(F.in[18], DM, DM, (bf16_t*)(ws + WS_WO), kb * 64, nb * 32, nb * 32, nullptr, scr, F.lane); continue; } r -= I_O;
        if (r < I_UP) { const int nb = r % (2 * DFF / 32), kb = r / (2 * DFF / 32), n0 = nb * 32, pn = n0 >> 8, j = n0 & 255, s0 = j < 128 ? pn * 128 + j : DFF + pn * 128 + (j - 128);
            p0_transpose_item(F.in[20], DM, 2 * DFF, (bf16_t*)(ws + WS_WUP), kb * 64, n0, s0, F.in[19], scr, F.lane); continue; } r -= I_UP;
        { const int nb = r % 32, kb = r / 32; p0_transpose_item(F.in[21], DFF, DM, (bf16_t*)(ws + WS_WDN), kb * 64, nb * 32, nb * 32, nullptr, scr, F.lane); }
    }
    const float* nmix = F.in[8];
    f32x4 gm[4];
#pragma unroll
    for (int j = 0; j < 4; ++j) gm[j] = *((const f32x4*)nmix + F.lane + 64 * j);
    float* Gd = (float*)(ws + WS_GB); float* Bd = Gd + (size_t)T * 4;
    for (int m = gw; m < T; m += NGW) {
        const float* xrow = m < TP ? F.in[0] + (size_t)m * DM : F.in[1] + (size_t)(m - TP) * DM;
        f32x4 v[4]; float s2 = 0.f;
#pragma unroll
        for (int j = 0; j < 4; ++j) { v[j] = *((const f32x4*)xrow + F.lane + 64 * j); s2 += (v[j].x * v[j].x + v[j].y * v[j].y) + (v[j].z * v[j].z + v[j].w * v[j].w); }
        const float rstd = __builtin_amdgcn_rsqf(wave_sum(s2) * (1.f / DM) + EPS);
        u32x2* o8 = (u32x2*)(ws + WS_XN + (size_t)m * DM * 2) + F.lane;
        float dot[8];
#pragma unroll
        for (int c = 0; c < 8; ++c) dot[c] = 0.f;
#pragma unroll
        for (int j = 0; j < 4; ++j) { v[j] = v[j] * rstd * gm[j]; u32x2 w; w.x = cvtpk(v[j].x, v[j].y); w.y = cvtpk(v[j].z, v[j].w); o8[64 * j] = w;
#pragma unroll
            for (int c = 0; c < 8; ++c) { const f32x4 ww = *((const LAS f32x4*)(w8t + c * 1024) + F.lane + 64 * j); dot[c] += (v[j].x * ww.x + v[j].y * ww.y) + (v[j].z * ww.z + v[j].w * ww.w); } }
#pragma unroll
        for (int c = 0; c < 8; ++c) dot[c] = wave_sum(dot[c]);
        if (F.lane < 4) {
            float a_raw = dot[0], b_raw = dot[4];
            if (F.lane == 1) { a_raw = dot[1]; b_raw = dot[5]; } else if (F.lane == 2) { a_raw = dot[2]; b_raw = dot[6]; } else if (F.lane == 3) { a_raw = dot[3]; b_raw = dot[7]; }
            const float xa = a_raw + F.in[13][F.lane];
            const float sp = xa > 20.f ? xa : log1pf(expf(xa));
            Gd[(size_t)m * 4 + F.lane] = -expf(F.in[12][F.lane]) * sp;
            Bd[(size_t)m * 4 + F.lane] = 1.f / (1.f + expf(-b_raw));
        }
    }
    const float* nmem = F.in[15];
#pragma unroll
    for (int j = 0; j < 4; ++j) gm[j] = *((const f32x4*)nmem + F.lane + 64 * j);
    for (int m = gw; m < NB * MEMT; m += NGW) {
        const float* xrow = F.in[2] + (size_t)m * DM;
        f32x4 v[4]; float s2 = 0.f;
#pragma unroll
        for (int j = 0; j < 4; ++j) { v[j] = *((const f32x4*)xrow + F.lane + 64 * j); s2 += (v[j].x * v[j].x + v[j].y * v[j].y) + (v[j].z * v[j].z + v[j].w * v[j].w); }
        const float rstd = __builtin_amdgcn_rsqf(wave_sum(s2) * (1.f / DM) + EPS);
        u32x2* o8 = (u32x2*)(ws + WS_MEMN + (size_t)m * DM * 2) + F.lane;
#pragma unroll
        for (int j = 0; j < 4; ++j) { v[j] = v[j] * rstd * gm[j]; u32x2 w; w.x = cvtpk(v[j].x, v[j].y); w.y = cvtpk(v[j].z, v[j].w); o8[64 * j] = w; }
    }
}

DI void p8_final(Frame& F, int dry) {
    const int gw = F.bid * 8 + F.wave, NGW = F.G * 8;
    const float* nf = F.in[22]; const float* ssq = (const float*)(F.ws + WS_SSQ2);
    f32x4 gm[4];
#pragma unroll
    for (int j = 0; j < 4; ++j) gm[j] = *((const f32x4*)nf + F.lane + 64 * j);
    for (int m = gw; m < T; m += NGW) {
        float s = F.lane < 16 ? ssq[(size_t)m * 16 + F.lane] : 0.f;
        s += __shfl_xor(s, 1); s += __shfl_xor(s, 2); s += __shfl_xor(s, 4); s += __shfl_xor(s, 8);
        s = __shfl(s, 0);
        const float rstd = __builtin_amdgcn_rsqf(s * (1.f / DM) + EPS);
        f32x4* xr = (f32x4*)(F.out + (size_t)m * DM) + F.lane;
#pragma unroll
        for (int j = 0; j < 4; ++j) { f32x4 v = xr[64 * j]; v = v * rstd * gm[j]; if (!dry || v.x == 123456.789f) xr[64 * j] = v; }
    }
}

DI int kperm(int a) { return (a & ~31) | (((a >> 2) & 3) << 3) | (((a >> 4) & 1) << 2) | (a & 3); }
DI int crow32(int reg, int hh) { return (reg & 3) + 8 * (reg >> 2) + 4 * hh; }
constexpr int D2_KB = 0, D2_QB = 17408, D2_AM = 34816, D2_REC = 51200, D2_UL = D2_REC + REC_BYTES  , D2_SM = D2_UL + 16384  ;
DI void p2_unit(Frame& F, int u) {
    const int b = u >> 7, c = (u >> 2) & 31, h = u & 3, ci = (b * 4 + h) * 32 + c;
    LAS unsigned char* L = F.lds;
    LAS float* sm = (LAS float*)(L + D2_SM);
    LAS float* s_dl = sm, *s_ed = sm + 64, *s_edl = sm + 128, *s_bt = sm + 192, *s_part = sm + 256, *s_rn = sm + 512, *s_bk = sm + 640;
    const bf16_t* P = (const bf16_t*)(F.ws + WS_P);
    const int tid = opaque_v(F.tid), w = opaque_s(F.wave), lane = tid & 63;
    const int tau = w >> 1, col = (w & 1) * 64 + lane;
    const size_t R0 = (size_t)b * SEQ + 64 * c;
    float val[64];
    if (w < 6) {
        const int pcol = (tau == 0 ? PC_V : (tau == 1 ? PC_K : PC_Q)) + h * 128 + col;
        const int chn = (tau == 0 ? 1024 : (tau == 1 ? 512 : 0)) + h * 128 + col;
        const float* cw = F.in[11];
        const float w0 = cw[chn], w1 = cw[1536 + chn], w2 = cw[2 * 1536 + chn], w3 = cw[3 * 1536 + chn];
        const bf16_t* px = P + (R0 - 3) * NP + pcol;
        float x0, x1, x2;
        if (c == 0) { x0 = 0.f; x1 = 0.f; x2 = 0.f; } else { x0 = bf2f(px[0]); x1 = bf2f(px[NP]); x2 = bf2f(px[2 * NP]); }
#pragma unroll
        for (int t = 0; t < 64; ++t) {
            const float x3 = bf2f(px[(size_t)(t + 3) * NP]);
            const float y = (w0 * x0 + w1 * x1) + (w2 * x2 + w3 * x3);
            val[t] = siluf_(y);
            x0 = x1; x1 = x2; x2 = x3;
        }
        if (c == 31) { float* o = F.out + O_DCP + (size_t)b * 3 * 1536 + chn; o[0] = x0; o[1536] = x1; o[2 * 1536] = x2; }
        if (tau != 0) {
            float r32[32];
#pragma unroll
            for (int t = 0; t < 32; ++t) { const float lo = val[t] * val[t], hi = val[t + 32] * val[t + 32]; const bool up = (lane & 32) != 0; const float keep = up ? hi : lo, send = up ? lo : hi; r32[t] = keep + __shfl_xor(send, 32); }
            float r16[16];
#pragma unroll
            for (int t = 0; t < 16; ++t) { const bool up = (lane & 16) != 0; const float keep = up ? r32[t + 16] : r32[t], send = up ? r32[t] : r32[t + 16]; r16[t] = keep + __shfl_xor(send, 16); }
            float r8[8];
#pragma unroll
            for (int t = 0; t < 8; ++t) { const bool up = (lane & 8) != 0; const float keep = up ? r16[t + 8] : r16[t], send = up ? r16[t] : r16[t + 8]; r8[t] = keep + __shfl_xor(send, 8); }
            float r4[4];
#pragma unroll
            for (int t = 0; t < 4; ++t) { const bool up = (lane & 4) != 0; const float keep = up ? r8[t + 4] : r8[t], send = up ? r8[t] : r8[t + 4]; r4[t] = keep + __shfl_xor(send, 4); }
            float r2[2];
#pragma unroll
            for (int t = 0; t < 2; ++t) { const bool up = (lane & 2) != 0; const float keep = up ? r4[t + 2] : r4[t], send = up ? r4[t] : r4[t + 2]; r2[t] = keep + __shfl_xor(send, 2); }
            { const bool up = (lane & 1) != 0; const float keep = up ? r2[1] : r2[0], send = up ? r2[0] : r2[1]; const float tot = keep + __shfl_xor(send, 1);
              s_part[((tau - 1) * 2 + (w & 1)) * 64 + lane] = tot; }
        }
    } else if (w == 6) {
        const float* Gd = (const float*)(F.ws + WS_GB); const float* Bd = Gd + (size_t)T * 4;
        const float g = Gd[(R0 + lane) * 4 + h], be = Bd[(R0 + lane) * 4 + h];
        float d = g;
#pragma unroll
        for (int o = 1; o < 64; o <<= 1) { const float t = __shfl_up(d, o); if (lane >= o) d += t; }
        const float dlast = __shfl(d, 63);
        s_dl[lane] = d; s_ed[lane] = __expf(d); s_edl[lane] = __expf(dlast - d); s_bt[lane] = be; s_bk[lane] = be * __expf(d);
        if (lane == 0) ((float*)(F.ws + WS_EDL))[ci] = __expf(dlast);
    }
    __syncthreads();
    if (tid < 128) { const int tt = tid >> 6, i = tid & 63; const float ss = s_part[(tt * 2) * 64 + i] + s_part[(tt * 2 + 1) * 64 + i];
        s_rn[tt * 64 + i] = __builtin_amdgcn_rsqf(ss + EPS) * (tt == 1 ? 0.08838834764831845f : 1.f); }
    __syncthreads();
    if (w >= 2 && w < 6) {
        LAS bf16_t* dst = (LAS bf16_t*)(L + (tau == 1 ? D2_KB : D2_QB));
#pragma unroll
        for (int t = 0; t < 64; ++t) { val[t] *= s_rn[(tau - 1) * 64 + t]; dst[t * 136 + col] = f2bf(val[t]); }
        if (tau == 1) {
            LAS bf16_t* kl = (LAS bf16_t*)(L + D2_REC + REC_KT);
#pragma unroll
            for (int i = 0; i < 64; ++i) kl[col * 64 + kperm(i)] = f2bf(val[i] * s_edl[i]);
        } else {
            LAS bf16_t* ql = (LAS bf16_t*)(L + D2_REC + REC_QD); const int pc = kperm(col);
#pragma unroll
            for (int i = 0; i < 64; ++i) ql[i * 128 + pc] = f2bf(val[i] * s_ed[i]);
        }
    }
    __syncthreads();
    if (w < 6) {
        const int mat = w / 3, tt = w % 3, ti = tt == 0 ? 0 : 1, tj = tt == 2 ? 1 : 0, r = lane & 31, hh = lane >> 5;
        const LAS unsigned char* ab = L + (mat == 0 ? D2_KB : D2_QB) + (32 * ti + r) * 272 + hh * 16;
        const LAS unsigned char* bb = L + D2_KB + (32 * tj + r) * 272 + hh * 16;
        f32x16 acc;
#pragma unroll
        for (int i = 0; i < 16; ++i) acc[i] = 0.f;
#pragma unroll
        for (int s = 0; s < 8; ++s) { const bf16x8 a = *(const LAS bf16x8*)(ab + s * 32), bq = *(const LAS bf16x8*)(bb + s * 32); acc = __builtin_amdgcn_mfma_f32_32x32x16_bf16(a, bq, acc, 0, 0, 0); }
        const int j = 32 * tj + r; const float dj = s_dl[j];
#pragma unroll
        for (int reg = 0; reg < 16; ++reg) { const int i = 32 * ti + crow32(reg, hh); const float di = s_dl[i];
            const float gam = (i >= j) ? __expf(di - dj) : 0.f;
            if (mat == 0) { ((LAS float*)(L + D2_AM))[i * 64 + j] = (i > j) ? s_bt[i] * acc[reg] * gam : 0.f; }
            else { ((LAS bf16_t*)(L + D2_REC + REC_QK))[i * 64 + kperm(j)] = f2bf(acc[reg] * gam); } }
    } else {
        const int t2 = tid - 384;
#pragma unroll
        for (int q = 0; q < 4; ++q) { const int idx = t2 + 128 * q, i = idx >> 4, c4 = idx & 15; *(LAS unsigned*)(L + D2_REC + REC_QK + (i * 64 + 32) * 2 + c4 * 4) = 0u; }
    }
    __syncthreads();
    if (w < 4) {
        const LAS f32x4* Am = (const LAS f32x4*)(L + D2_AM);
        const LAS float* rsc = (tau == 1) ? s_bk : s_bt;
#pragma unroll
        for (int i = 0; i < 64; ++i) {
            float a0 = val[i] * rsc[i];
            float a1 = 0.f, a2 = 0.f, a3 = 0.f;
#pragma unroll
            for (int j4 = 0; j4 < (i + 3) / 4; ++j4) { const f32x4 a = Am[i * 16 + j4];
                if (4 * j4 + 0 < i) a0 -= a.x * val[4 * j4 + 0];
                if (4 * j4 + 1 < i) a1 -= a.y * val[4 * j4 + 1];
                if (4 * j4 + 2 < i) a2 -= a.z * val[4 * j4 + 2];
                if (4 * j4 + 3 < i) a3 -= a.w * val[4 * j4 + 3];
                if ((j4 & 3) == 3) asm volatile("" ::: "memory"); }
            val[i] = (a0 + a1) + (a2 + a3);
            asm volatile("" ::: "memory");
        }
        if (tau == 0) {
            LAS bf16_t* ul = (LAS bf16_t*)(L + D2_UL);
#pragma unroll
            for (int i = 0; i < 64; ++i) ul[(((col >> 4) * 4 + (i >> 4)) * 64 + (((i & 15) >> 2) * 16 + (col & 15))) * 4 + (i & 3)] = f2bf(val[i]);
        } else {
            LAS bf16_t* wl = (LAS bf16_t*)(L + D2_REC + REC_W); const int pc = kperm(col);
#pragma unroll
            for (int i = 0; i < 64; ++i) wl[i * 128 + pc] = f2bf(-val[i]);
        }
    }
    __syncthreads();
    {
        unsigned char* rec = (unsigned char*)F.out + OS_REC + (size_t)ci * REC_BYTES;
#pragma unroll
        for (int i = 0; i < 7; ++i) { const int q = tid + 512 * i; *(u32x4*)(rec + q * 16) = *(const LAS u32x4*)(L + D2_REC + q * 16); }
        unsigned char* ub = F.ws + WS_UBUF + (size_t)ci * 16384;
#pragma unroll
        for (int i = 0; i < 2; ++i) { const int q = tid + 512 * i; *(u32x4*)(ub + q * 16) = *(const LAS u32x4*)(L + D2_UL + q * 16); }
    }
    __syncthreads();
}

constexpr int D3_LW = 0, D3_LQD = 17408, D3_LKT = 34816, D3_LQK = 53248, D3_BUF = 62464;
DI void d3_store_rec(LAS unsigned char* buf, const u32x4 (&rg)[7], int tid) {
#pragma unroll
    for (int i = 0; i < 7; ++i) { const int q = tid + 512 * i; int off;
        if (i < 2) off = D3_LW + (q >> 4) * 272 + (q & 15) * 16;
        else if (i < 4) { const int q2 = q - 1024; off = D3_LQD + (q2 >> 4) * 272 + (q2 & 15) * 16; }
        else if (i < 6) { const int q2 = q - 2048; off = D3_LKT + (q2 >> 3) * 144 + (q2 & 7) * 16; }
        else { const int q2 = q - 3072; off = D3_LQK + (q2 >> 3) * 144 + (q2 & 7) * 16; }
        *(LAS u32x4*)(buf + off) = rg[i]; }
}
DI bf16x8 pack8(const f32x4& a, const f32x4& b) { u32x4 p; p.x = cvtpk(a[0], a[1]); p.y = cvtpk(a[2], a[3]); p.z = cvtpk(b[0], b[1]); p.w = cvtpk(b[2], b[3]); return __builtin_bit_cast(bf16x8, p); }
constexpr int D3_OL = 2 * D3_BUF, D3_OSTR = 132;
DI void d3_store_rec14(LAS unsigned char* buf, const u32x4 (&rg)[14], int ht) {
#pragma unroll
    for (int i = 0; i < 14; ++i) { const int q = ht + 256 * i; int off;
        if (i < 4) off = D3_LW + (q >> 4) * 272 + (q & 15) * 16;
        else if (i < 8) { const int q2 = q - 1024; off = D3_LQD + (q2 >> 4) * 272 + (q2 & 15) * 16; }
        else if (i < 12) { const int q2 = q - 2048; off = D3_LKT + (q2 >> 3) * 144 + (q2 & 7) * 16; }
        else { const int q2 = q - 3072; off = D3_LQK + (q2 >> 3) * 144 + (q2 & 7) * 16; }
        *(LAS u32x4*)(buf + off) = rg[i]; }
}
DI void p3_scan(Frame& F, int bh, int dry) {
    const int b = bh >> 2, h = bh & 3;
    const int tid = opaque_v(F.tid), w = opaque_s(F.wave), lane = tid & 63;
    LAS unsigned char* L = F.lds;
    LAS float* OL = (LAS float*)(L + D3_OL);
    bf16_t* P = (bf16_t*)(F.ws + WS_P);
    const unsigned char* rec0 = (const unsigned char*)F.out + OS_REC + (size_t)(bh * 32) * REC_BYTES;
    const unsigned char* ub0 = F.ws + WS_UBUF + (size_t)(bh * 32) * 16384;
    const float* edlp = (const float*)(F.ws + WS_EDL) + bh * 32;
    if (w < 4) {
        const int fr = lane & 15, g = lane >> 4;
        f32x4 Sacc[8][2]; bf16x8 Sb[4][2];
#pragma unroll
        for (int i = 0; i < 8; ++i) { Sacc[i][0] = (f32x4){0.f, 0.f, 0.f, 0.f}; Sacc[i][1] = (f32x4){0.f, 0.f, 0.f, 0.f}; }
#pragma unroll
        for (int i = 0; i < 4; ++i) { Sb[i][0] = (bf16x8){0, 0, 0, 0, 0, 0, 0, 0}; Sb[i][1] = (bf16x8){0, 0, 0, 0, 0, 0, 0, 0}; }
        u32x2 ufn[4][2]; float edln = edlp[0];
#pragma unroll
        for (int mt = 0; mt < 4; ++mt)
#pragma unroll
            for (int nt = 0; nt < 2; ++nt) ufn[mt][nt] = *(const u32x2*)(ub0 + ((((2 * w + nt) * 4 + mt) * 64 + lane) * 4) * 2);
        __syncthreads();
#define D3_SCHED __builtin_amdgcn_sched_barrier(0)
#define D3_LD_WQ(dst, bufp, mt) do { _Pragma("unroll") for (int s_ = 0; s_ < 4; ++s_) { \
            dst[s_] = *(const LAS bf16x8*)((bufp) + D3_LW + (16 * (mt) + fr) * 272 + (32 * s_ + 8 * g) * 2); \
            dst[4 + s_] = *(const LAS bf16x8*)((bufp) + D3_LQD + (16 * (mt) + fr) * 272 + (32 * s_ + 8 * g) * 2); } } while (0)
#define D3_LD_QK(dst, bufp) do { _Pragma("unroll") for (int m_ = 0; m_ < 4; ++m_) _Pragma("unroll") for (int s_ = 0; s_ < 2; ++s_) \
            dst[2 * m_ + s_] = *(const LAS bf16x8*)((bufp) + D3_LQK + (16 * m_ + fr) * 144 + (32 * s_ + 8 * g) * 2); } while (0)
#define D3_LD_KT(dst, bufp, m0) do { _Pragma("unroll") for (int m_ = 0; m_ < 4; ++m_) _Pragma("unroll") for (int s_ = 0; s_ < 2; ++s_) \
            dst[2 * m_ + s_] = *(const LAS bf16x8*)((bufp) + D3_LKT + (16 * ((m0) + m_) + fr) * 144 + (32 * s_ + 8 * g) * 2); } while (0)
#define D3_MM_WQ(src, mt) do { _Pragma("unroll") for (int s_ = 0; s_ < 4; ++s_) _Pragma("unroll") for (int nt = 0; nt < 2; ++nt) { \
            VN[mt][nt] = __builtin_amdgcn_mfma_f32_16x16x32_bf16(src[s_], Sb[s_][nt], VN[mt][nt], 0, 0, 0); \
            O[mt][nt] = __builtin_amdgcn_mfma_f32_16x16x32_bf16(src[4 + s_], Sb[s_][nt], O[mt][nt], 0, 0, 0); } } while (0)
#define D3_MM_KT(src, m0) do { _Pragma("unroll") for (int m_ = 0; m_ < 4; ++m_) _Pragma("unroll") for (int s_ = 0; s_ < 2; ++s_) _Pragma("unroll") for (int nt = 0; nt < 2; ++nt) \
            Sacc[(m0) + m_][nt] = __builtin_amdgcn_mfma_f32_16x16x32_bf16(src[2 * m_ + s_], VNb[s_][nt], Sacc[(m0) + m_][nt], 0, 0, 0); } while (0)
        bf16x8 fa[8], fb[8];
        D3_LD_WQ(fa, L, 0);
        for (int c = 0; c < 32; ++c) {
            const LAS unsigned char* buf = L + (c & 1) * D3_BUF;
            f32x4 VN[4][2], O[4][2];
#pragma unroll
            for (int mt = 0; mt < 4; ++mt)
#pragma unroll
                for (int nt = 0; nt < 2; ++nt) { const u32x2 u = ufn[mt][nt]; VN[mt][nt] = (f32x4){bflo(u.x), bfhi(u.x), bflo(u.y), bfhi(u.y)}; O[mt][nt] = (f32x4){0.f, 0.f, 0.f, 0.f}; }
            const float edl = edln;
            if (c + 1 < 32) { edln = edlp[c + 1];
#pragma unroll
                for (int mt = 0; mt < 4; ++mt)
#pragma unroll
                    for (int nt = 0; nt < 2; ++nt) ufn[mt][nt] = *(const u32x2*)(ub0 + (size_t)(c + 1) * 16384 + ((((2 * w + nt) * 4 + mt) * 64 + lane) * 4) * 2); }
            D3_SCHED;
            D3_LD_WQ(fb, buf, 1); D3_SCHED; D3_MM_WQ(fa, 0); D3_SCHED;
            D3_LD_WQ(fa, buf, 2); D3_SCHED; D3_MM_WQ(fb, 1); D3_SCHED;
            D3_LD_WQ(fb, buf, 3); D3_SCHED; D3_MM_WQ(fa, 2); D3_SCHED;
            D3_LD_QK(fa, buf);    D3_SCHED; D3_MM_WQ(fb, 3); D3_SCHED;
            bf16x8 VNb[2][2];
#pragma unroll
            for (int nt = 0; nt < 2; ++nt) { VNb[0][nt] = pack8(VN[0][nt], VN[1][nt]); VNb[1][nt] = pack8(VN[2][nt], VN[3][nt]); }
            D3_LD_KT(fb, buf, 0); D3_SCHED;
#pragma unroll
            for (int mt = 0; mt < 4; ++mt)
#pragma unroll
                for (int s = 0; s < 2; ++s)
#pragma unroll
                    for (int nt = 0; nt < 2; ++nt) O[mt][nt] = __builtin_amdgcn_mfma_f32_16x16x32_bf16(fa[2 * mt + s], VNb[s][nt], O[mt][nt], 0, 0, 0);
#pragma unroll
            for (int m8 = 0; m8 < 8; ++m8) { Sacc[m8][0] = Sacc[m8][0] * edl; Sacc[m8][1] = Sacc[m8][1] * edl; }
            D3_SCHED;
            D3_LD_KT(fa, buf, 4); D3_SCHED; D3_MM_KT(fb, 0); D3_SCHED;
            D3_MM_KT(fa, 4); D3_SCHED;
#pragma unroll
            for (int s = 0; s < 4; ++s)
#pragma unroll
                for (int nt = 0; nt < 2; ++nt) Sb[s][nt] = pack8(Sacc[2 * s][nt], Sacc[2 * s + 1][nt]);
            __syncthreads();
            if (c + 1 < 32) D3_LD_WQ(fa, L + ((c + 1) & 1) * D3_BUF, 0);
#pragma unroll
            for (int mt = 0; mt < 4; ++mt)
#pragma unroll
                for (int nt = 0; nt < 2; ++nt)
#pragma unroll
                    for (int r = 0; r < 4; ++r) OL[(16 * mt + 4 * g + r) * D3_OSTR + 32 * w + 16 * nt + fr] = O[mt][nt][r];
            __syncthreads();
        }
        float* so = F.out + O_SP + (size_t)bh * 128 * 128 + 32 * w + fr;
#pragma unroll
        for (int m8 = 0; m8 < 8; ++m8)
#pragma unroll
            for (int nt = 0; nt < 2; ++nt)
#pragma unroll
                for (int r = 0; r < 4; ++r) so[(size_t)(16 * m8 + 4 * g + r) * 128 + 16 * nt] = Sacc[m8][nt][r];
    } else {
        const int ht = tid - 256, tok = ht >> 2, q4 = ht & 3;
        u32x4 rg[14];
#pragma unroll
        for (int i = 0; i < 14; ++i) rg[i] = *(const u32x4*)(rec0 + (ht + 256 * i) * 16);
        float gn[32];
#pragma unroll
        for (int j = 0; j < 8; ++j) { const f32x4 v = *(const f32x4*)(F.in[14] + 32 * q4 + 4 * j); gn[4 * j] = v.x; gn[4 * j + 1] = v.y; gn[4 * j + 2] = v.z; gn[4 * j + 3] = v.w; }
        bf16_t* zbase = P + ((size_t)b * SEQ + tok) * NP + PC_Z + h * 128 + 32 * q4;
        u32x4 zc[4], zp_[4];
#pragma unroll
        for (int j = 0; j < 4; ++j) { zc[j] = *(const u32x4*)(zbase + 8 * j); zp_[j] = zc[j]; }
        d3_store_rec14(L, rg, ht);
        __syncthreads();
        for (int c = 0; c <= 32; ++c) {
            if (c + 1 < 32) {
#pragma unroll
                for (int i = 0; i < 14; ++i) rg[i] = *(const u32x4*)(rec0 + (size_t)(c + 1) * REC_BYTES + (ht + 256 * i) * 16);
            }
            if (c > 0) {
#pragma unroll
                for (int j = 0; j < 4; ++j) zp_[j] = zc[j];
                if (c < 32) {
#pragma unroll
                    for (int j = 0; j < 4; ++j) zc[j] = *(const u32x4*)(zbase + (size_t)64 * c * NP + 8 * j);
                }
                float o[32]; float ss = 0.f;
#pragma unroll
                for (int j = 0; j < 8; ++j) { const f32x4 v = *(const LAS f32x4*)(OL + tok * D3_OSTR + 32 * q4 + 4 * j); o[4 * j] = v.x; o[4 * j + 1] = v.y; o[4 * j + 2] = v.z; o[4 * j + 3] = v.w;
                    ss += (v.x * v.x + v.y * v.y) + (v.z * v.z + v.w * v.w); }
                ss += __shfl_xor(ss, 1); ss += __shfl_xor(ss, 2);
                const float rs = __builtin_amdgcn_rsqf(ss * (1.f / 128.f) + EPS);
                bf16_t* yp = zbase + (size_t)64 * (c - 1) * NP;
#pragma unroll
                for (int j = 0; j < 4; ++j) { u32x4 ow;
#pragma unroll
                    for (int q = 0; q < 4; ++q) { const float z0 = bflo(zp_[j][q]), z1 = bfhi(zp_[j][q]);
                        ow[q] = cvtpk(o[8 * j + 2 * q] * rs * gn[8 * j + 2 * q] * siluf_(z0), o[8 * j + 2 * q + 1] * rs * gn[8 * j + 2 * q + 1] * siluf_(z1)); }
                    if (!dry) *(u32x4*)(yp + 8 * j) = ow; }
            }
            if (c == 32) break;
            if (c + 1 < 32) d3_store_rec14(L + ((c + 1) & 1) * D3_BUF, rg, ht);
            __syncthreads();
            __syncthreads();
        }
    }
}

DI void p3_conv_unit(Frame& F, int u, int dry) {
    bf16_t* P = (bf16_t*)(F.ws + WS_P);
    const int tid = opaque_v(F.tid);
    const int rg = tid >> 6, c0 = (tid & 63) * 8;
    const float* cw = F.in[10];
    float w0[8], w1[8], w2[8];
#pragma unroll
    for (int j = 0; j < 8; ++j) { w0[j] = cw[c0 + j]; w1[j] = cw[512 + c0 + j]; w2[j] = cw[1024 + c0 + j]; }
    float p0[8], p1[8];
    size_t row0; bool has_prev; const float* st = nullptr;
    if (u < 512) { row0 = (size_t)u * 32 + rg * 4; has_prev = (row0 % SEQ) != 0; }
    else { const int bb = (u - 512) * 8 + rg; row0 = (size_t)TP + bb * 4; has_prev = false; st = F.in[3] + (size_t)bb * 2 * 512 + c0; }
    if (st) {
#pragma unroll
        for (int j = 0; j < 8; ++j) { p0[j] = st[j]; p1[j] = st[512 + j]; }
    } else if (has_prev) {
        const u32x4 ca = *(const u32x4*)(P + (row0 - 2) * NP + PC_C + c0), ha = *(const u32x4*)(P + (row0 - 2) * NP + PC_H + c0);
        const u32x4 cb = *(const u32x4*)(P + (row0 - 1) * NP + PC_C + c0), hb = *(const u32x4*)(P + (row0 - 1) * NP + PC_H + c0);
#pragma unroll
        for (int q = 0; q < 4; ++q) { p0[2 * q] = bflo(ca[q]) * bflo(ha[q]); p0[2 * q + 1] = bfhi(ca[q]) * bfhi(ha[q]); p1[2 * q] = bflo(cb[q]) * bflo(hb[q]); p1[2 * q + 1] = bfhi(cb[q]) * bfhi(hb[q]); }
    } else {
#pragma unroll
        for (int j = 0; j < 8; ++j) { p0[j] = 0.f; p1[j] = 0.f; }
    }
#pragma unroll
    for (int i = 0; i < 4; ++i) {
        bf16_t* pr = P + (row0 + i) * NP + c0;
        const u32x4 bv = *(const u32x4*)(pr + PC_B), cv = *(const u32x4*)(pr + PC_C), hv = *(const u32x4*)(pr + PC_H);
        float cur[8], y[8];
#pragma unroll
        for (int q = 0; q < 4; ++q) { cur[2 * q] = bflo(cv[q]) * bflo(hv[q]); cur[2 * q + 1] = bfhi(cv[q]) * bfhi(hv[q]); }
#pragma unroll
        for (int q = 0; q < 4; ++q) {
            y[2 * q] = bflo(bv[q]) * (w0[2 * q] * p0[2 * q] + w1[2 * q] * p1[2 * q] + w2[2 * q] * cur[2 * q]);
            y[2 * q + 1] = bfhi(bv[q]) * (w0[2 * q + 1] * p0[2 * q + 1] + w1[2 * q + 1] * p1[2 * q + 1] + w2[2 * q + 1] * cur[2 * q + 1]); }
        u32x4 o; o.x = cvtpk(y[0], y[1]); o.y = cvtpk(y[2], y[3]); o.z = cvtpk(y[4], y[5]); o.w = cvtpk(y[6], y[7]);
        if (!dry) *(u32x4*)(pr + PC_B) = o;
        const size_t r = row0 + i;
        if (u < 512) { const int t = (int)(r % SEQ); if (t >= SEQ - 2) { float* o2 = F.out + O_CAP + ((size_t)(r / SEQ) * 2 + (t - (SEQ - 2))) * 512 + c0;
#pragma unroll
                for (int j = 0; j < 8; ++j) o2[j] = cur[j]; } }
        else if (i >= 2) { const int bb = (u - 512) * 8 + rg; float* o2 = F.out + O_CAS + ((size_t)bb * 2 + (i - 2)) * 512 + c0;
#pragma unroll
            for (int j = 0; j < 8; ++j) o2[j] = cur[j]; }
#pragma unroll
        for (int j = 0; j < 8; ++j) { p0[j] = p1[j]; p1[j] = cur[j]; }
    }
}

constexpr int AT_K = 0, AT_KSTR = 272, AT_VT = 256 * AT_KSTR  , AT_VSTR = 520;
DI void p3_attn_unit(Frame& F, int u, int dry) {
    const int tid = opaque_v(F.tid), w = opaque_s(F.wave), lane = tid & 63;
    const int b = u >> 5, h = (u >> 3) & 3, qb = u & 7, r = lane & 31, hh = lane >> 5;
    LAS unsigned char* L = F.lds;
    bf16_t* P = (bf16_t*)(F.ws + WS_P);
    const bf16_t* KB = (const bf16_t*)((const unsigned char*)F.out + OS_KB) + (size_t)b * 256 * 512 + h * 128;
    const bf16_t* VT = (const bf16_t*)((const unsigned char*)F.out + OS_VT) + (size_t)(b * 4 + h) * 128 * 256;
#pragma unroll
    for (int i = 0; i < 8; ++i) { const int q = tid + 512 * i; const int row = q >> 4, cp = q & 15;
        *(LAS u32x4*)(L + AT_K + row * AT_KSTR + cp * 16) = *(const u32x4*)(KB + (size_t)row * 512 + cp * 8); }
#pragma unroll
    for (int i = 0; i < 8; ++i) { const int q = tid + 512 * i; const int row = q >> 5, cp = q & 31;
        const u32x4 v = *(const u32x4*)(VT + (size_t)row * 256 + cp * 8);
        *(LAS u32x2*)(L + AT_VT + row * AT_VSTR + cp * 16) = (u32x2){v.x, v.y}; *(LAS u32x2*)(L + AT_VT + row * AT_VSTR + cp * 16 + 8) = (u32x2){v.z, v.w}; }
    const size_t qrow = (size_t)b * SEQ + qb * 256 + w * 32 + r;
    bf16_t* qp = P + qrow * NP + PC_XQ + h * 128;
    bf16x8 qf[8];
#pragma unroll
    for (int s = 0; s < 8; ++s) qf[s] = *(const bf16x8*)(qp + 16 * s + 8 * hh);
    __syncthreads();
    f32x16 S[8];
#pragma unroll
    for (int kt = 0; kt < 8; ++kt) {
#pragma unroll
        for (int i = 0; i < 16; ++i) S[kt][i] = 0.f;
#pragma unroll
        for (int s = 0; s < 8; ++s) { const bf16x8 kf = *(const LAS bf16x8*)(L + AT_K + (32 * kt + r) * AT_KSTR + (16 * s + 8 * hh) * 2);
            S[kt] = __builtin_amdgcn_mfma_f32_32x32x16_bf16(kf, qf[s], S[kt], 0, 0, 0); }
    }
    float mx = -3.0e38f;
#pragma unroll
    for (int kt = 0; kt < 8; ++kt)
#pragma unroll
        for (int i = 0; i < 16; ++i) mx = fmaxf(mx, S[kt][i]);
    mx = fmaxf(mx, __shfl_xor(mx, 32));
    const float sc = 0.08838834764831845f * 1.4426950408889634f;
    float sum = 0.f;
#pragma unroll
    for (int kt = 0; kt < 8; ++kt)
#pragma unroll
        for (int i = 0; i < 16; ++i) { const float p = __builtin_amdgcn_exp2f((S[kt][i] - mx) * sc); S[kt][i] = p; sum += p; }
    sum += __shfl_xor(sum, 32);
    const float inv = 1.f / sum;
    f32x16 O[4];
#pragma unroll
    for (int dt = 0; dt < 4; ++dt)
#pragma unroll
        for (int i = 0; i < 16; ++i) O[dt][i] = 0.f;
#pragma unroll
    for (int kt = 0; kt < 8; ++kt)
#pragma unroll
        for (int s = 0; s < 2; ++s) {
            u32x4 pk; pk.x = cvtpk(S[kt][8 * s + 0] * inv, S[kt][8 * s + 1] * inv); pk.y = cvtpk(S[kt][8 * s + 2] * inv, S[kt][8 * s + 3] * inv);
            pk.z = cvtpk(S[kt][8 * s + 4] * inv, S[kt][8 * s + 5] * inv); pk.w = cvtpk(S[kt][8 * s + 6] * inv, S[kt][8 * s + 7] * inv);
            const bf16x8 pf = __builtin_bit_cast(bf16x8, pk);
#pragma unroll
            for (int dt = 0; dt < 4; ++dt) {
                const LAS unsigned char* vp = L + AT_VT + (32 * dt + r) * AT_VSTR + (32 * kt + 16 * s + 4 * hh) * 2;
                const u32x2 lo = *(const LAS u32x2*)vp, hi = *(const LAS u32x2*)(vp + 16);
                const bf16x8 vf = __builtin_bit_cast(bf16x8, (u32x4){lo.x, lo.y, hi.x, hi.y});
                O[dt] = __builtin_amdgcn_mfma_f32_32x32x16_bf16(pf, vf, O[dt], 0, 0, 0);
            }
        }
    bf16_t* op = P + ((size_t)b * SEQ + qb * 256 + w * 32) * NP + PC_XQ + h * 128 + r;
#pragma unroll
    for (int dt = 0; dt < 4; ++dt)
#pragma unroll
        for (int i = 0; i < 16; ++i) { if (!dry) op[(size_t)crow32(i, hh) * NP + 32 * dt] = f2bf(O[dt][i]); }
    __syncthreads();
}

DI void p3_sattn_unit(Frame& F, int u, int dry) {
    const int tid = opaque_v(F.tid), w = opaque_s(F.wave), lane = tid & 63;
    const int b = u >> 2, h = u & 3, l5 = lane & 31, hh = lane >> 5;
    LAS float* sc = (LAS float*)F.lds;
    LAS float* red = sc + 1024;
    bf16_t* P = (bf16_t*)(F.ws + WS_P);
    bf16_t* qp = P + ((size_t)TP + b * 4) * NP + PC_XQ + h * 128;
    float q[4][4];
#pragma unroll
    for (int t = 0; t < 4; ++t) { const u32x2 v = *(const u32x2*)(qp + (size_t)t * NP + 4 * l5); q[t][0] = bflo(v.x); q[t][1] = bfhi(v.x); q[t][2] = bflo(v.y); q[t][3] = bfhi(v.y); }
    const float* kc = F.in[6] + ((size_t)b * 256 * 4 + h) * 128 + 4 * l5;
    const float* vc = F.in[7] + ((size_t)b * 256 * 4 + h) * 128 + 4 * l5;
    __syncthreads();
    f32x4 kv[16];
#pragma unroll
    for (int i = 0; i < 16; ++i) kv[i] = *(const f32x4*)(kc + (size_t)(32 * w + 2 * i + hh) * 512);
#pragma unroll
    for (int i = 0; i < 16; ++i) {
        float d[4];
#pragma unroll
        for (int t = 0; t < 4; ++t) { d[t] = (kv[i].x * q[t][0] + kv[i].y * q[t][1]) + (kv[i].z * q[t][2] + kv[i].w * q[t][3]);
            d[t] += __shfl_xor(d[t], 1); d[t] += __shfl_xor(d[t], 2); d[t] += __shfl_xor(d[t], 4); d[t] += __shfl_xor(d[t], 8); d[t] += __shfl_xor(d[t], 16); }
        if (l5 == 0) *(LAS f32x4*)(sc + (32 * w + 2 * i + hh) * 4) = (f32x4){d[0], d[1], d[2], d[3]};
    }
    f32x4 vv[16];
#pragma unroll
    for (int i = 0; i < 16; ++i) vv[i] = *(const f32x4*)(vc + (size_t)(32 * w + 16 * hh + i) * 512);
    __syncthreads();
    if (w < 4) {
        float s[4]; float mx = -3.0e38f;
#pragma unroll
        for (int j = 0; j < 4; ++j) { s[j] = sc[(lane + 64 * j) * 4 + w] * 0.08838834764831845f; mx = fmaxf(mx, s[j]); }
#pragma unroll
        for (int o = 1; o < 64; o <<= 1) mx = fmaxf(mx, __shfl_xor(mx, o));
        float sum = 0.f;
#pragma unroll
        for (int j = 0; j < 4; ++j) { s[j] = __expf(s[j] - mx); sum += s[j]; }
        sum = wave_sum(sum);
        const float inv = 1.f / sum;
#pragma unroll
        for (int j = 0; j < 4; ++j) sc[(lane + 64 * j) * 4 + w] = s[j] * inv;
    }
    __syncthreads();
    float acc[4][4];
#pragma unroll
    for (int t = 0; t < 4; ++t)
#pragma unroll
        for (int j = 0; j < 4; ++j) acc[t][j] = 0.f;
#pragma unroll
    for (int i = 0; i < 16; ++i) { const f32x4 p = *(const LAS f32x4*)(sc + (32 * w + 16 * hh + i) * 4);
#pragma unroll
        for (int t = 0; t < 4; ++t) { acc[t][0] += p[t] * vv[i].x; acc[t][1] += p[t] * vv[i].y; acc[t][2] += p[t] * vv[i].z; acc[t][3] += p[t] * vv[i].w; } }
#pragma unroll
    for (int t = 0; t < 4; ++t) *(LAS f32x4*)(red + ((2 * w + hh) * 4 + t) * 128 + 4 * l5) = (f32x4){acc[t][0], acc[t][1], acc[t][2], acc[t][3]};
    __syncthreads();
    { const int t = tid >> 7, d = tid & 127; float o = 0.f;
#pragma unroll
      for (int gq = 0; gq < 16; ++gq) o += red[(gq * 4 + t) * 128 + d];
      if (!dry) qp[(size_t)t * NP + d] = f2bf(o); }
}

DI void p3_sdn_unit(Frame& F, int u4, int dry) {
    const int tid = opaque_v(F.tid), lane = tid & 63, wh = opaque_s(F.wave) & 1;
    const int grp = tid >> 7, e = tid & 127, u = u4 * 4 + grp, b = u >> 2, h = u & 3;
    LAS float* base = (LAS float*)F.lds + grp * 1280;
    LAS float* s_k = base, *s_q = base + 512, *s_part = base + 1024, *s_tot = base + 1056;
    bf16_t* P = (bf16_t*)(F.ws + WS_P);
    const size_t row0 = (size_t)TP + b * 4;
    const float* cw = F.in[11]; const float* cs = F.in[4] + (size_t)b * 3 * 1536;
    float qv[4], kv[4], vv[4];
#pragma unroll
    for (int tau = 0; tau < 3; ++tau) {
        const int chn = tau * 512 + h * 128 + e;
        const float w0 = cw[chn], w1 = cw[1536 + chn], w2 = cw[2 * 1536 + chn], w3 = cw[3 * 1536 + chn];
        float x0 = cs[chn], x1 = cs[1536 + chn], x2 = cs[2 * 1536 + chn];
        float* dco = F.out + O_DCS + (size_t)b * 3 * 1536 + chn;
#pragma unroll
        for (int t = 0; t < 4; ++t) { const float x3 = bf2f(P[(row0 + t) * NP + PC_Q + chn]);
            const float y = siluf_((w0 * x0 + w1 * x1) + (w2 * x2 + w3 * x3));
            if (tau == 0) qv[t] = y; else if (tau == 1) kv[t] = y; else vv[t] = y;
            if (t >= 1) dco[(size_t)(t - 1) * 1536] = x3;
            x0 = x1; x1 = x2; x2 = x3; }
    }
    __syncthreads();
#pragma unroll
    for (int t = 0; t < 4; ++t) { const float a = wave_sum(qv[t] * qv[t]), c = wave_sum(kv[t] * kv[t]); if (lane == 0) { s_part[wh * 12 + t] = a; s_part[wh * 12 + 4 + t] = c; } }
    __syncthreads();
    if (e < 8) s_tot[e] = s_part[e] + s_part[12 + e];
    __syncthreads();
#pragma unroll
    for (int t = 0; t < 4; ++t) { qv[t] *= __builtin_amdgcn_rsqf(s_tot[t] + EPS) * 0.08838834764831845f; kv[t] *= __builtin_amdgcn_rsqf(s_tot[4 + t] + EPS);
        s_k[t * 128 + e] = kv[t]; s_q[t * 128 + e] = qv[t]; }
    const float* Gd = (const float*)(F.ws + WS_GB); const float* Bd = Gd + (size_t)T * 4;
    float s[128];
    const float* sp = F.in[5] + ((size_t)(b * 4 + h) * 128) * 128 + e;
#pragma unroll
    for (int j0 = 0; j0 < 128; j0 += 8) {
#pragma unroll
        for (int jj = 0; jj < 8; ++jj) s[j0 + jj] = sp[jj * 128];
        sp += 8 * 128; asm volatile("" : "+v"(sp)); }
    __syncthreads();
    float ov[4];
#pragma unroll
    for (int t = 0; t < 4; ++t) {
        const float a = __expf(Gd[(row0 + t) * 4 + h]), be = Bd[(row0 + t) * 4 + h];
        float r0 = 0.f, r1 = 0.f, r2 = 0.f, r3 = 0.f;
#pragma unroll
        for (int j4 = 0; j4 < 32; ++j4) { const f32x4 kk = *(const LAS f32x4*)(s_k + t * 128 + 4 * j4);
            s[4 * j4] *= a; s[4 * j4 + 1] *= a; s[4 * j4 + 2] *= a; s[4 * j4 + 3] *= a;
            r0 += kk.x * s[4 * j4]; r1 += kk.y * s[4 * j4 + 1]; r2 += kk.z * s[4 * j4 + 2]; r3 += kk.w * s[4 * j4 + 3];
            if ((j4 & 3) == 3) asm volatile("" : "+v"(r0), "+v"(r1), "+v"(r2), "+v"(r3) :: "memory"); }
        const float vn = be * (vv[t] - ((r0 + r1) + (r2 + r3)));
        float o0 = 0.f, o1 = 0.f, o2 = 0.f, o3 = 0.f;
        const LAS float* k2 = s_k + t * 128; asm volatile("" : "+v"(k2));
#pragma unroll
        for (int j4 = 0; j4 < 32; ++j4) { const f32x4 kk = *(const LAS f32x4*)(k2 + 4 * j4); const f32x4 qq = *(const LAS f32x4*)(s_q + t * 128 + 4 * j4);
            s[4 * j4] += kk.x * vn; s[4 * j4 + 1] += kk.y * vn; s[4 * j4 + 2] += kk.z * vn; s[4 * j4 + 3] += kk.w * vn;
            o0 += qq.x * s[4 * j4]; o1 += qq.y * s[4 * j4 + 1]; o2 += qq.z * s[4 * j4 + 2]; o3 += qq.w * s[4 * j4 + 3];
            if ((j4 & 3) == 3) asm volatile("" : "+v"(o0), "+v"(o1), "+v"(o2), "+v"(o3) :: "memory"); }
        ov[t] = (o0 + o1) + (o2 + o3);
    }
    float* so = F.out + O_SS + ((size_t)(b * 4 + h) * 128) * 128 + e;
#pragma unroll
    for (int j0 = 0; j0 < 128; j0 += 8) {
#pragma unroll
        for (int jj = 0; jj < 8; ++jj) so[jj * 128] = s[j0 + jj];
        so += 8 * 128; asm volatile("" : "+v"(so)); }
#pragma unroll
    for (int t = 0; t < 4; ++t) { const float a = wave_sum(ov[t] * ov[t]); if (lane == 0) s_part[wh * 12 + 8 + t] = a; }
    __syncthreads();
    if (e < 4) s_tot[8 + e] = s_part[8 + e] + s_part[12 + 8 + e];
    __syncthreads();
    const float gn = F.in[14][e];
#pragma unroll
    for (int t = 0; t < 4; ++t) { bf16_t* zp = P + (row0 + t) * NP + PC_Z + h * 128 + e; const float z = bf2f(*zp);
        const bf16_t yv = f2bf(ov[t] * __builtin_amdgcn_rsqf(s_tot[8 + t] * (1.f / 128.f) + EPS) * gn * siluf_(z)); if (!dry) *zp = yv; }
}

constexpr int N_PHASES = 9;
__global__ void __launch_bounds__(512, 2) fwd_kernel(Args args) {
    extern __shared__ __attribute__((aligned(16))) unsigned char lds_raw[];
    Frame F;
    F.lds = (LAS unsigned char*)lds_raw;
    F.tid = threadIdx.x; F.lane = F.tid & 63; F.wave = __builtin_amdgcn_readfirstlane(F.tid >> 6);
    F.G = gridDim.x; F.bid = blockIdx.x;
#pragma unroll
    for (int i = 0; i < 23; ++i) F.in[i] = args.in[i];
    F.out = args.out; F.ws = args.ws;
    volatile LAS unsigned* MISC = (volatile LAS unsigned*)(F.lds + MISC_OFF);
    if (F.tid < 64) MISC[F.tid] = 0u;
    __syncthreads();
    const int lo = args.ph_lo, hi = args.ph_hi;
    const bool one = (hi - lo) > 1;
    XcdBarrier bar; bar.bar = (unsigned*)(F.ws + WS_CTL); bar.x = 0; bar.st = nullptr;
    if (one) bar = xcd_barrier_post((unsigned*)(F.ws + WS_CTL), MISC + 8);
#ifndef PHASE_MASK
#define PHASE_MASK 0x1ff
#endif
#define IN(k) (((PHASE_MASK >> (k)) & 1) && lo <= (k) && (k) < hi)
#define SEAM(k) do { if (IN(k) && IN((k) + 1)) xcd_barrier(bar); } while (0)
    unsigned char* ws = F.ws;

    if (IN(0)) { p0_prologue(F); } SEAM(0);

    if (IN(1)) {
        { pg8::Gemm g{(const bf16_t*)(ws + WS_XN), (const bf16_t*)(ws + WS_WIN), T, NP, DM, DM}; pg8::StaticOrder S; S.init(T, NP, F.G, F.bid);
          pg8::EpiP E{(bf16_t*)(ws + WS_P), NP};
          pg8::gemm_phase<pg8::EpiP, false, true, true>(F.lds, g, S, E); }
        { pg8::Gemm g{(const bf16_t*)(ws + WS_MEMN), (const bf16_t*)(ws + WS_WKV), NB * MEMT, DM, DM, DM}; pg8::StaticOrder S;
          const int rot = ((T / 256) * (NP / 256)) % F.G;
          S.init(NB * MEMT, DM, F.G, (F.bid + F.G - (rot & ~7)) % F.G);
          pg8::EpiKV E{F.out + O_MK, F.out + O_MV, (bf16_t*)((unsigned char*)F.out + OS_KB), (bf16_t*)((unsigned char*)F.out + OS_VT)};
          pg8::gemm_phase<pg8::EpiKV, false, true, true>(F.lds, g, S, E); }
    } SEAM(1);

    if (IN(2)) { for (int u = F.bid; u < 1024; u += F.G) p2_unit(F, u); } SEAM(2);

    if (IN(3)) {
        if (F.bid < 32) { if (args.sub != 2 && args.sub != 5) p3_scan(F, F.bid, args.sub == 3); }
        else if (args.sub != 1 && args.sub != 3) {
            const int j0 = F.bid - 32, st = F.G - 32, dry = args.sub == 5;
            for (int u = j0; u < 1424; u += st) {
                if (u < 256) p3_attn_unit(F, u, dry);
                else if (u < 768) p3_sattn_unit(F, u - 256, dry);
                else if (u < 896) p3_sdn_unit(F, u - 768, dry);
                else p3_conv_unit(F, u - 896, dry);
            }
        }
    } SEAM(3);

    if (IN(4)) {
        pg8::Gemm g{(const bf16_t*)(ws + WS_P), (const bf16_t*)(ws + WS_WBR), T, DM, 1536, NP}; pg8::StaticOrder S; S.init(T, DM, F.G, F.bid);
        pg8::EpiMerge E{(const bf16_t*)(ws + WS_P), (bf16_t*)(ws + WS_MG)};
        pg8::gemm_phase<pg8::EpiMerge, true, true, true>(F.lds, g, S, E);
    } SEAM(4);

    if (IN(5)) {
        pg8::Gemm g{(const bf16_t*)(ws + WS_MG), (const bf16_t*)(ws + WS_WO), T, DM, DM, DM}; pg8::StaticOrder S; S.init(T, DM, F.G, F.bid);
        pg8::EpiRes E{F.in[0], F.in[1], (float*)(ws + WS_X1), (bf16_t*)(ws + WS_X1B), (float*)(ws + WS_SSQ1)};
        pg8::gemm_phase<pg8::EpiRes, false, true, true>(F.lds, g, S, E);
    } SEAM(5);

    if (IN(6)) {
        pg8::Gemm g{(const bf16_t*)(ws + WS_X1B), (const bf16_t*)(ws + WS_WUP), T, 2 * DFF, DM, DM}; pg8::StaticOrder S; S.init(T, 2 * DFF, F.G, F.bid);
        pg8::EpiUp E{(const float*)(ws + WS_SSQ1), (bf16_t*)(ws + WS_H)};
        pg8::gemm_phase<pg8::EpiUp, false, true, true>(F.lds, g, S, E);
    } SEAM(6);

    if (IN(7)) {
        pg8::Gemm g{(const bf16_t*)(ws + WS_H), (const bf16_t*)(ws + WS_WDN), T, DM, DFF, DFF}; pg8::StaticOrder S; S.init(T, DM, F.G, F.bid);
        pg8::EpiRes E{(const float*)(ws + WS_X1), (const float*)(ws + WS_X1) + (size_t)TP * DM, F.out, nullptr, (float*)(ws + WS_SSQ2)};
        pg8::gemm_phase<pg8::EpiRes, false, true, true>(F.lds, g, S, E);
    } SEAM(7);

    if (IN(8)) { p8_final(F, args.sub == 4); }
#undef IN
#undef SEAM
}

#ifndef MK_ONE_LAUNCH
#define MK_ONE_LAUNCH 1
#endif
extern "C" void kernel_launch(void* const* d_in, const int* in_sizes, int n_in, void* d_out, int out_size, void* d_ws, size_t ws_size, hipStream_t stream) {
    static int grid = 0;
    if (grid == 0) {
        if (n_in != 23 || out_size != (int)O_END || ws_size < WS_END) { fprintf(stderr, "kernel_launch: unexpected sizes n_in %d out %d ws %zu (need %zu)\n", n_in, out_size, ws_size, (size_t)WS_END); grid = -1; return; }
        int dev = 0, cus = 0, per_cu = 0;
        if (hipGetDevice(&dev) != hipSuccess || hipDeviceGetAttribute(&cus, hipDeviceAttributeMultiprocessorCount, dev) != hipSuccess) { grid = -1; return; }
        if (hipFuncSetAttribute((const void*)fwd_kernel, hipFuncAttributeMaxDynamicSharedMemorySize, LDS_BYTES) != hipSuccess) { fprintf(stderr, "kernel_launch: hipFuncSetAttribute failed\n"); grid = -1; return; }
        if (hipOccupancyMaxActiveBlocksPerMultiprocessor(&per_cu, (const void*)fwd_kernel, 512, LDS_BYTES) != hipSuccess || per_cu < 1) { fprintf(stderr, "kernel_launch: occupancy query says %d blocks per CU\n", per_cu); (void)hipGetLastError(); grid = -1; return; }
        grid = cus;
        if (grid <= 64) { fprintf(stderr, "kernel_launch: %d CUs is too few for this kernel's phase split\n", grid); grid = -1; return; }
    }
    if (grid < 0) return;
    Args a{};
    for (int i = 0; i < 23; ++i) a.in[i] = (const float*)d_in[i];
    a.out = (float*)d_out; a.ws = (unsigned char*)d_ws;
#if MK_ONE_LAUNCH
    (void)hipMemsetAsync((char*)d_ws + WS_CTL, 0, CTL_BYTES, stream);
    a.ph_lo = 0; a.ph_hi = N_PHASES;
    void* kargs[] = {&a};
    hipError_t e = hipLaunchCooperativeKernel((const void*)fwd_kernel, dim3(grid), dim3(512), kargs, LDS_BYTES, stream);
    if (e != hipSuccess) fprintf(stderr, "kernel_launch: cooperative launch failed: %s\n", hipGetErrorString(e));
#else
#ifndef PROBE_REP
#define PROBE_REP 0x000
#endif
    for (int p = 0; p < N_PHASES; ++p) { const int reps = ((PROBE_REP >> p) & 1) ? 2 : 1;
        for (int r = 0; r < reps; ++r) { a.ph_lo = p; a.ph_hi = p + 1;
#ifdef PROBE_SPLIT3
            if (p == 3) { a.sub = 1; hipLaunchKernelGGL(fwd_kernel, dim3(grid), dim3(512), LDS_BYTES, stream, a); a.sub = 2; }
#endif
#ifdef PROBE_DRY8
            if (p == 8) { a.sub = 4; hipLaunchKernelGGL(fwd_kernel, dim3(grid), dim3(512), LDS_BYTES, stream, a); a.sub = 0; }
#endif
#ifdef PROBE_DRYOTH
            if (p == 3) { a.sub = 5; hipLaunchKernelGGL(fwd_kernel, dim3(grid), dim3(512), LDS_BYTES, stream, a); a.sub = 0; }
#endif
#ifdef PROBE_DRYSCAN
            if (p == 3) { a.sub = 3; hipLaunchKernelGGL(fwd_kernel, dim3(grid), dim3(512), LDS_BYTES, stream, a); a.sub = 0; }
#endif
            hipLaunchKernelGGL(fwd_kernel, dim3(grid), dim3(512), LDS_BYTES, stream, a); a.sub = 0; } }
#endif
}
```
